# Optimizing an MI355X kernel written in HIP

```python
import jax, jax.numpy as jnp
from jax import lax
import numpy as np

D_MODEL = 1024
BATCH = 8
SEQ = 2048
DEPTH = 2

GRID_W = 64
CTX_LEN = 256
D_MIX = D_MODEL
D_RET = D_MIX // 2
D_RWKV = D_MIX - D_RET
HEAD_DIM = 64
N_RET_HEADS = D_RET // HEAD_DIM
N_RWKV_HEADS = D_RWKV // HEAD_DIM
RET_CHUNK = 128
LORA_W = 64
LORA_A = 64
SHIFT_K = 3
D_SHIFT = 3 * D_RWKV + LORA_W + LORA_A
D_IN = 4 * D_RET + D_SHIFT + D_RWKV
ROPE_BASE = 10000.0
NORM_EPS = 1e-6
RWKV_GN_EPS = 64e-5
IN_SPLITS = [D_RET, 2 * D_RET, 3 * D_RET, 4 * D_RET, 4 * D_RET + D_SHIFT]
RWKV_SPLITS = [D_RWKV, 2 * D_RWKV, 3 * D_RWKV, 3 * D_RWKV + LORA_W]

kernel_name = 'hymba_retention_rwkv7_prefix_dit'


def rms_norm(x, w):
    xf = x.astype(jnp.float32)
    return xf * lax.rsqrt(jnp.mean(xf * xf, axis=-1, keepdims=True) + NORM_EPS) * w


def adaln(cond, w_mod, b_mod):
    m = jax.nn.silu(cond.astype(jnp.float32)) @ w_mod + b_mod
    return jnp.split(m, 3, axis=-1)


def to_heads(t, n_heads):
    b, l, _ = t.shape
    return t.astype(jnp.float32).reshape(b, l, n_heads, HEAD_DIM).transpose(0, 2, 1, 3)


def rope_1d(xh, pos):
    nf = xh.shape[-1] // 2
    inv = ROPE_BASE ** (-jnp.arange(nf, dtype=jnp.float32) / nf)
    ang = pos[:, None] * inv[None, :]
    cos, sin = jnp.cos(ang), jnp.sin(ang)
    x1, x2 = xh[..., :nf], xh[..., nf:]
    return jnp.concatenate([x1 * cos - x2 * sin, x1 * sin + x2 * cos], axis=-1)


def rope_2d(x, row_pos, col_pos):
    half = x.shape[-1] // 2
    return jnp.concatenate([rope_1d(x[..., :half], row_pos), rope_1d(x[..., half:], col_pos)], axis=-1)


def retention_scan(q, k, v, log_gamma, s0):
    b, h, l, dh = q.shape
    n_chunks = l // RET_CHUNK
    to_chunks = lambda t: t.reshape(b, h, n_chunks, RET_CHUNK, dh).transpose(2, 0, 1, 3, 4)
    lg = log_gamma.astype(jnp.float32)[:, None]
    idx = jnp.arange(RET_CHUNK, dtype=jnp.float32)
    rel = idx[:, None] - idx[None, :]
    decay_mask = jnp.where(rel >= 0, jnp.exp(lg[:, :, None] * jnp.maximum(rel, 0.0)), 0.0)
    q_decay = jnp.exp(lg * (idx + 1.0))[:, :, None]
    k_decay = jnp.exp(lg * (RET_CHUNK - 1.0 - idx))[:, :, None]
    chunk_decay = jnp.exp(lg * RET_CHUNK)[:, :, None]

    def step(s, qkv):
        qc, kc, vc = qkv
        scores = jnp.einsum('bhid,bhjd->bhij', qc, kc) * decay_mask
        inner = jnp.einsum('bhij,bhjd->bhid', scores, vc)
        cross = jnp.einsum('bhid,bhde->bhie', qc * q_decay, s)
        s_new = s * chunk_decay + jnp.einsum('bhjd,bhje->bhde', kc * k_decay, vc)
        return s_new, inner + cross

    s_fin, o = lax.scan(step, s0, (to_chunks(q), to_chunks(k), to_chunks(v)))
    return o.transpose(1, 2, 0, 3, 4).reshape(b, h, l, dh), s_fin


def head_norm_merge(o, norm_w):
    o = o * lax.rsqrt(jnp.mean(o * o, axis=-1, keepdims=True) + NORM_EPS)
    b, h, l, dh = o.shape
    return o.transpose(0, 2, 1, 3).reshape(b, l, h * dh) * norm_w


def retention_branch(ql, kl, vl, qc, kc, vc, row_pos, col_pos, log_gamma, norm_w):
    hd = lambda t: to_heads(t, N_RET_HEADS)
    scale = HEAD_DIM ** -0.5
    ql = rope_2d(hd(ql), row_pos, col_pos)
    kl = rope_2d(hd(kl), row_pos, col_pos) * scale
    vl = hd(vl)
    qc, kc, vc = hd(qc), hd(kc) * scale, hd(vc)
    s0 = jnp.zeros((ql.shape[0], N_RET_HEADS, HEAD_DIM, HEAD_DIM), jnp.float32)
    fl = lambda t: jnp.flip(t, axis=2)
    oc_f, sc_f = retention_scan(qc, kc, vc, log_gamma[0], s0)
    ol_f, _ = retention_scan(ql, kl, vl, log_gamma[0], sc_f)
    oc_b, sc_b = retention_scan(fl(qc), fl(kc), fl(vc), log_gamma[1], s0)
    ol_b, _ = retention_scan(fl(ql), fl(kl), fl(vl), log_gamma[1], sc_b)
    out_l = head_norm_merge(ol_f + fl(ol_b), norm_w)
    out_c = head_norm_merge(oc_f + fl(oc_b), norm_w)
    return out_l, out_c


def centred_conv(x, w):
    k_size = w.shape[0]
    pad = k_size // 2
    l = x.shape[1]
    xp = jnp.pad(x, ((0, 0), (pad, pad), (0, 0)))
    return sum(xp[:, i:i + l] * w[i] for i in range(k_size))


def rwkv7_scan(r, w, k, v, kap, a, s0, reverse):
    xs = tuple(jnp.swapaxes(t, 0, 1) for t in (r, w, k, v, kap, a))

    def step(s, inp):
        r_t, w_t, k_t, v_t, kap_t, a_t = inp
        s_kap = jnp.einsum('bhvk,bhk->bhv', s, kap_t)
        s = (s * w_t[:, :, None, :]
             - s_kap[..., None] * (kap_t * a_t)[:, :, None, :]
             + v_t[..., None] * k_t[:, :, None, :])
        return s, jnp.einsum('bhvk,bhk->bhv', s, r_t)

    s_fin, y = lax.scan(step, s0, xs, reverse=reverse)
    return jnp.swapaxes(y, 0, 1), s_fin


def rwkv_branch(pl, pc, shift_w, w0, w2, a0, a2, k_k, k_a, r_k, ln_w, ln_b):
    def features(p):
        h = centred_conv(p.astype(jnp.float32), shift_w)
        r, k, v, xw, xa = jnp.split(h, RWKV_SPLITS, axis=-1)
        b, l, _ = r.shape
        hs = lambda t: t.reshape(b, l, N_RWKV_HEADS, HEAD_DIM)
        kk = hs(k * k_k)
        kk = kk / jnp.maximum(jnp.sqrt(jnp.sum(kk * kk, axis=-1, keepdims=True)), 1e-12)
        dirs = []
        for d in range(2):
            w_log = -jax.nn.softplus(-(w0[d] + jnp.tanh(xw) @ w2[d])) - 0.5
            decay = jnp.exp(-jnp.exp(w_log))
            a = jax.nn.sigmoid(a0[d] + xa @ a2[d])
            k_mod = k * (1.0 + (a - 1.0) * k_a)
            dirs.append((hs(r), hs(decay), hs(k_mod), hs(v), kk, hs(a)))
        bonus = jnp.sum(hs(r) * hs(k) * r_k, axis=-1, keepdims=True) * hs(v)
        return dirs, bonus

    def readout(y, bonus):
        mu = jnp.mean(y, axis=-1, keepdims=True)
        var = jnp.mean(jnp.square(y - mu), axis=-1, keepdims=True)
        y = (y - mu) * lax.rsqrt(var + RWKV_GN_EPS) * ln_w.reshape(N_RWKV_HEADS, HEAD_DIM) \
            + ln_b.reshape(N_RWKV_HEADS, HEAD_DIM) + bonus
        b, l = y.shape[:2]
        return y.reshape(b, l, D_RWKV)

    dirs_c, bonus_c = features(pc)
    dirs_l, bonus_l = features(pl)
    s0 = jnp.zeros((pl.shape[0], N_RWKV_HEADS, HEAD_DIM, HEAD_DIM), jnp.float32)
    y_c, y_l = 0.0, 0.0
    for d in range(2):
        rev = d == 1
        yc, sc = rwkv7_scan(*dirs_c[d], s0, rev)
        yl, _ = rwkv7_scan(*dirs_l[d], sc, rev)
        y_c = y_c + yc
        y_l = y_l + yl
    return readout(y_l, bonus_l), readout(y_c, bonus_c)


def setup_inputs(seed: int = 0) -> dict:
    key = jax.random.key(seed)
    ks = jax.random.split(key, 24)
    f32 = jnp.float32
    nrm = lambda k, shape, s: jax.random.normal(k, shape, f32) * s
    x = nrm(ks[0], (BATCH, SEQ, D_MODEL), 1.0)
    c = nrm(ks[1], (BATCH, D_MODEL), 1.0)
    ctx = nrm(ks[2], (BATCH, CTX_LEN, D_MODEL), 1.0)
    c_ctx = nrm(ks[3], (D_MODEL,), 1.0)
    norm_w = 1.0 + nrm(ks[4], (DEPTH, D_MODEL), 0.05)
    w_mod = nrm(ks[5], (DEPTH, D_MODEL, 3 * D_MODEL), 0.5 * D_MODEL ** -0.5)
    b_mod = nrm(ks[6], (DEPTH, 3 * D_MODEL), 0.02)
    w_in = nrm(ks[7], (DEPTH, D_MODEL, D_IN), D_MODEL ** -0.5)
    base_lg = jnp.asarray(np.log(1.0 - 2.0 ** (-5.0 - np.arange(N_RET_HEADS))).astype(np.float32))
    ret_log_gamma = base_lg * jnp.exp(nrm(ks[8], (DEPTH, 2, N_RET_HEADS), 0.1))
    ret_norm_w = 1.0 + nrm(ks[9], (DEPTH, D_RET), 0.05)
    base_shift = jnp.array([0.25, 0.5, 0.25], f32)[:, None]
    rwkv_shift_w = base_shift + nrm(ks[10], (DEPTH, SHIFT_K, D_SHIFT), 0.1)
    rwkv_w0 = jnp.linspace(-4.0, 1.0, D_RWKV, dtype=f32) + nrm(ks[11], (DEPTH, 2, D_RWKV), 0.2)
    rwkv_w2 = nrm(ks[12], (DEPTH, 2, LORA_W, D_RWKV), 0.5 * LORA_W ** -0.5)
    rwkv_a0 = nrm(ks[13], (DEPTH, 2, D_RWKV), 0.1)
    rwkv_a2 = nrm(ks[14], (DEPTH, 2, LORA_A, D_RWKV), 0.5 * LORA_A ** -0.5)
    rwkv_k_k = 0.85 + nrm(ks[15], (DEPTH, D_RWKV), 0.05)
    rwkv_k_a = 1.0 + nrm(ks[16], (DEPTH, D_RWKV), 0.05)
    rwkv_r_k = nrm(ks[17], (DEPTH, N_RWKV_HEADS, HEAD_DIM), 0.1)
    rwkv_ln_w = 1.0 + nrm(ks[18], (DEPTH, D_RWKV), 0.05)
    rwkv_ln_b = nrm(ks[19], (DEPTH, D_RWKV), 0.02)
    w_out = nrm(ks[20], (DEPTH, D_MIX, D_MODEL), D_MIX ** -0.5)
    final_norm_w = 1.0 + nrm(ks[21], (D_MODEL,), 0.05)
    return {'x': x, 'c': c, 'ctx': ctx, 'c_ctx': c_ctx, 'norm_w': norm_w, 'w_mod': w_mod,
            'b_mod': b_mod, 'w_in': w_in, 'ret_log_gamma': ret_log_gamma, 'ret_norm_w': ret_norm_w,
            'rwkv_shift_w': rwkv_shift_w, 'rwkv_w0': rwkv_w0, 'rwkv_w2': rwkv_w2, 'rwkv_a0': rwkv_a0,
            'rwkv_a2': rwkv_a2, 'rwkv_k_k': rwkv_k_k, 'rwkv_k_a': rwkv_k_a, 'rwkv_r_k': rwkv_r_k,
            'rwkv_ln_w': rwkv_ln_w, 'rwkv_ln_b': rwkv_ln_b, 'w_out': w_out, 'final_norm_w': final_norm_w}


def reference(x, c, ctx, c_ctx, norm_w, w_mod, b_mod, w_in, ret_log_gamma, ret_norm_w,
              rwkv_shift_w, rwkv_w0, rwkv_w2, rwkv_a0, rwkv_a2, rwkv_k_k, rwkv_k_a, rwkv_r_k,
              rwkv_ln_w, rwkv_ln_b, w_out, final_norm_w):
    f32 = jnp.float32
    seq_len = x.shape[1]
    ROWS = seq_len // GRID_W
    row_pos = jnp.repeat(jnp.arange(ROWS, dtype=f32), GRID_W)
    col_pos = jnp.tile(jnp.arange(GRID_W, dtype=f32), ROWS)
    xl, xc = x, ctx
    for layer in range(DEPTH):
        sh_l, sc_l, g_l = adaln(c, w_mod[layer], b_mod[layer])
        sh_c, sc_c, g_c = adaln(c_ctx, w_mod[layer], b_mod[layer])
        hl = rms_norm(xl, norm_w[layer]) * (1.0 + sc_l[:, None]) + sh_l[:, None]
        hc = rms_norm(xc, norm_w[layer]) * (1.0 + sc_c) + sh_c
        pl = hl @ w_in[layer]
        pc = hc @ w_in[layer]
        ql, kl, vl, gr_l, rw_l, gw_l = jnp.split(pl, IN_SPLITS, axis=-1)
        qc, kc, vc, gr_c, rw_c, gw_c = jnp.split(pc, IN_SPLITS, axis=-1)
        ret_l, ret_c = retention_branch(ql, kl, vl, qc, kc, vc, row_pos, col_pos,
                                        ret_log_gamma[layer], ret_norm_w[layer])
        rwo_l, rwo_c = rwkv_branch(rw_l, rw_c, rwkv_shift_w[layer], rwkv_w0[layer], rwkv_w2[layer],
                                   rwkv_a0[layer], rwkv_a2[layer], rwkv_k_k[layer], rwkv_k_a[layer],
                                   rwkv_r_k[layer], rwkv_ln_w[layer], rwkv_ln_b[layer])
        mix_l = jnp.concatenate([ret_l * jax.nn.silu(gr_l), rwo_l * jax.nn.silu(gw_l)], axis=-1) @ w_out[layer]
        xl = xl + g_l[:, None] * mix_l
        if layer < DEPTH - 1:
            mix_c = jnp.concatenate([ret_c * jax.nn.silu(gr_c), rwo_c * jax.nn.silu(gw_c)], axis=-1) @ w_out[layer]
            xc = xc + g_c * mix_c
    return rms_norm(xl, final_norm_w)
```

```cpp
#include <hip/hip_runtime.h>
#include <hip/hip_fp16.h>
#include <hip/hip_cooperative_groups.h>
#include <cstdio>
namespace cg = cooperative_groups;

typedef _Float16 h16;
typedef _Float16 half8 __attribute__((ext_vector_type(8)));
typedef _Float16 half4 __attribute__((ext_vector_type(4)));
typedef float f32x4 __attribute__((ext_vector_type(4)));

constexpr int NB = 8, SEQ = 2048, CTXL = 256, DM = 1024;
constexpr int MLAT = NB * SEQ, MCTX = NB * CTXL, MTOT = MLAT + MCTX;
constexpr int DIN = 4224, HD = 64, DSHIFT = 1664;
constexpr int NTHR = 512;
constexpr float NORM_EPS = 1e-6f, GN_EPS = 64e-5f;

constexpr size_t OFF_P = 0;
constexpr size_t SZ_P = (size_t)MTOT * DIN * 2;
constexpr size_t OFF_H = OFF_P + SZ_P;
constexpr size_t SZ_H = (size_t)MTOT * DM * 2;
constexpr size_t OFF_Y = OFF_H + SZ_H;
constexpr size_t SZ_Y = (size_t)2 * MTOT * 512 * 2;
constexpr size_t OFF_XC = OFF_Y + SZ_Y;
constexpr size_t SZ_XC = (size_t)MCTX * DM * 4;
constexpr size_t OFF_WIN = OFF_XC + SZ_XC;
constexpr size_t SZ_WIN = (size_t)DIN * DM * 2;
constexpr size_t OFF_WOUT = OFF_WIN + 2 * SZ_WIN;
constexpr size_t SZ_WOUT = (size_t)DM * DM * 2;
constexpr size_t OFF_MOD = OFF_WOUT + 2 * SZ_WOUT;
constexpr size_t SZ_MOD = (size_t)2 * 9 * 3072 * 4;
constexpr size_t OFF_ROPE = OFF_MOD + SZ_MOD;
constexpr size_t SZ_ROPE = 64 * 16 * 2 * 4;
constexpr size_t OFF_BAR = OFF_ROPE + SZ_ROPE;
constexpr size_t SZ_BAR = 3456 * 4;
constexpr size_t WS_END = OFF_BAR + SZ_BAR;

constexpr size_t SEC_Q = 0, SEC_K = (size_t)MTOT * 512, SEC_V = (size_t)MTOT * 1024, SEC_GR = (size_t)MTOT * 1536,
                 SEC_RW = (size_t)MTOT * 2048, SEC_GW = (size_t)MTOT * 3712;

constexpr int SMEM_BYTES = 143360;

struct Params {
  const float *x, *c, *ctx, *c_ctx, *norm_w, *w_mod, *b_mod, *w_in, *ret_lg, *ret_nw, *shift_w, *w0, *w2, *a0, *a2,
      *k_k, *k_a, *r_k, *ln_w, *ln_b, *w_out, *fnw;
  float* out;
  unsigned char* ws;
};

__device__ __forceinline__ int TID(int w) {
  int t;
  asm volatile("v_mbcnt_lo_u32_b32 %0, -1, 0\n\tv_mbcnt_hi_u32_b32 %0, -1, %0\n\tv_lshl_or_b32 %0, %1, 6, %0" : "=&v"(t) : "s"(w));
  return t;
}
__device__ __forceinline__ int BID() { int t; asm volatile("s_mov_b32 %0, %1" : "=s"(t) : "s"((int)blockIdx.x)); return t; }

__device__ __forceinline__ float shx(float v, int lane, int m) {
  return __builtin_bit_cast(float, __builtin_amdgcn_ds_bpermute((lane ^ m) << 2, __builtin_bit_cast(int, v)));
}
__device__ __forceinline__ float wave_sum(float v, int lane) {
#pragma unroll
  for (int o = 1; o < 64; o <<= 1) v += shx(v, lane, o);
  return v;
}
template <int CTRL>
__device__ __forceinline__ float dppf(float x) {
  return __builtin_bit_cast(float, __builtin_amdgcn_update_dpp(0, __builtin_bit_cast(int, x), CTRL, 0xF, 0xF, true));
}
__device__ __forceinline__ float reduce8(float x) {
  x += dppf<0xB1>(x);
  x += dppf<0x4E>(x);
  x += dppf<0x141>(x);
  return x;
}
__device__ __forceinline__ float reduce16(float x) {
  x = reduce8(x);
  x += dppf<0x140>(x);
  return x;
}
__device__ __forceinline__ void lds_barrier() { asm volatile("s_waitcnt lgkmcnt(0)" ::: "memory"); __builtin_amdgcn_s_barrier(); asm volatile("" ::: "memory"); }
__device__ __forceinline__ float silu_f(float x) { return x / (1.f + expf(-x)); }

__device__ void transpose_item(const float* W, int N, h16* WT, int K, int item, float* tile, int wv) {
  const int tid = TID(wv);
  const int nblk = N / 64, kb = item / nblk, nbk = item % nblk, k0 = kb * 64, n0 = nbk * 64;
#pragma unroll
  for (int i = 0; i < 2; ++i) {
    const int r = (tid >> 4) + i * 32, c4 = (tid & 15) * 4;
    const float4 v = *(const float4*)(W + (size_t)(k0 + r) * N + n0 + c4);
    tile[r * 65 + c4 + 0] = v.x; tile[r * 65 + c4 + 1] = v.y; tile[r * 65 + c4 + 2] = v.z; tile[r * 65 + c4 + 3] = v.w;
  }
  __syncthreads();
  {
    const int n = tid >> 3, k8 = (tid & 7) * 8;
    half8 o;
#pragma unroll
    for (int i = 0; i < 8; ++i) o[i] = (h16)tile[(k8 + i) * 65 + n];
    *(half8*)(WT + (size_t)(n0 + n) * K + k0 + k8) = o;
  }
  __syncthreads();
}
__device__ void convert_weights(const Params& p, int blk, int nblk, unsigned char* smem, int wv) {
  constexpr int I_IN = (DM / 64) * (DIN / 64), I_OUT = (DM / 64) * (DM / 64), I_L = I_IN + I_OUT;
  float* tile = (float*)smem;
  for (int it = blk; it < 2 * I_L; it += nblk) {
    const int layer = it / I_L, r = it % I_L;
    if (r < I_IN) transpose_item(p.w_in + (size_t)layer * DM * DIN, DIN, (h16*)(p.ws + OFF_WIN + (size_t)layer * SZ_WIN), DM, r, tile, wv);
    else transpose_item(p.w_out + (size_t)layer * DM * DM, DM, (h16*)(p.ws + OFF_WOUT + (size_t)layer * SZ_WOUT), DM, r - I_IN, tile, wv);
  }
}

__device__ void phase_adaln(const Params& p_, unsigned char* smem, int wv) {
  (void)p_;
  auto kp_ = __builtin_amdgcn_kernarg_segment_ptr();
  asm volatile("" : "+s"(kp_));
  const Params p = *(const Params*)kp_;
  const int bid = BID();
  const int tid = TID(wv);
  float* scond = (float*)smem;
  float* red = scond + 9 * 1024;
  float* mod = (float*)(p.ws + OFF_MOD);
  const int nblocks = gridDim.x;
  if (bid == nblocks - 1) {
    float2* tab = (float2*)(p.ws + OFF_ROPE);
    for (int i = tid; i < 1024; i += NTHR) {
      const int pos = i >> 4, f = i & 15;
      const float inv = powf(10000.f, -(float)f * (1.f / 16.f));
      float sn, cs;
      sincosf((float)pos * inv, &sn, &cs);
      tab[i] = float2{cs, sn};
    }
  }
  if (bid < 96) {
    for (int i = tid; i < 9 * 1024; i += NTHR) {
      const int ci = i >> 10, k = i & 1023;
      const float v = ci < 8 ? p.c[ci * 1024 + k] : p.c_ctx[k];
      scond[i] = silu_f(v);
    }
    __syncthreads();
    for (int it = bid; it < 96; it += nblocks) {
      const int l = it / 48, nb = it % 48;
      const int kg = tid >> 6, nl = tid & 63, n = nb * 64 + nl;
      const float* wm = p.w_mod + (size_t)l * DM * 3072 + n;
      float acc[9];
#pragma unroll
      for (int i = 0; i < 9; ++i) acc[i] = 0.f;
#pragma unroll 4
      for (int k = kg * 128; k < kg * 128 + 128; ++k) {
        const float wv = wm[(size_t)k * 3072];
#pragma unroll
        for (int i = 0; i < 9; ++i) acc[i] += scond[i * 1024 + k] * wv;
      }
#pragma unroll
      for (int i = 0; i < 9; ++i) red[(kg * 9 + i) * 64 + nl] = acc[i];
      __syncthreads();
      for (int idx = tid; idx < 576; idx += NTHR) {
        const int i = idx >> 6, nn = idx & 63;
        float s = p.b_mod[l * 3072 + nb * 64 + nn];
#pragma unroll
        for (int g = 0; g < 8; ++g) s += red[(g * 9 + i) * 64 + nn];
        mod[((size_t)l * 9 + i) * 3072 + nb * 64 + nn] = s;
      }
      __syncthreads();
    }
    if (nblocks <= 96) convert_weights(p, bid, nblocks, smem, wv);
  } else {
    convert_weights(p, bid - 96, nblocks - 96, smem, wv);
  }
}

__device__ __forceinline__ const float* xrow_ptr(const Params& p, int layer, int row) {
  if (layer == 0) return row < MLAT ? p.x + (size_t)row * DM : p.ctx + (size_t)(row - MLAT) * DM;
  return row < MLAT ? p.out + (size_t)row * DM : (const float*)(p.ws + OFF_XC) + (size_t)(row - MLAT) * DM;
}
__device__ void phase_norm(const Params& p_, int layer, int wv) {
  (void)p_;
  auto kp_ = __builtin_amdgcn_kernarg_segment_ptr();
  asm volatile("" : "+s"(kp_));
  const Params p = *(const Params*)kp_;
  const int bid = BID();
  const int tid_ = TID(wv); const int lane = tid_ & 63, wave = tid_ >> 6;
  const float* mod = (const float*)(p.ws + OFF_MOD) + (size_t)layer * 9 * 3072;
  h16* H = (h16*)(p.ws + OFF_H);
  const float* nw = p.norm_w + layer * DM;
  const int nwv = gridDim.x * 8;
  for (int row = bid * 8 + wave; row < MTOT; row += 2 * nwv) {
    const int row2 = row + nwv;
    const bool has2 = row2 < MTOT;
    const float* xr = xrow_ptr(p, layer, row);
    const float* xr2 = xrow_ptr(p, layer, has2 ? row2 : row);
    float4 v[4], w[4];
    float ss = 0.f, ss2 = 0.f;
#pragma unroll
    for (int j = 0; j < 4; ++j) { v[j] = *(const float4*)(xr + j * 256 + lane * 4); w[j] = *(const float4*)(xr2 + j * 256 + lane * 4); }
#pragma unroll
    for (int j = 0; j < 4; ++j) {
      ss += v[j].x * v[j].x + v[j].y * v[j].y + v[j].z * v[j].z + v[j].w * v[j].w;
      ss2 += w[j].x * w[j].x + w[j].y * w[j].y + w[j].z * w[j].z + w[j].w * w[j].w;
    }
    ss = wave_sum(ss, lane);
    ss2 = wave_sum(ss2, lane);
#pragma unroll
    for (int q = 0; q < 2; ++q) {
      if (q == 1 && !has2) break;
      const int rr = q ? row2 : row;
      const float rstd = rsqrtf((q ? ss2 : ss) * (1.f / DM) + NORM_EPS);
      const int cond = rr < MLAT ? (rr >> 11) : 8;
      const float* sh = mod + cond * 3072;
      const float* sc = sh + 1024;
#pragma unroll
      for (int j = 0; j < 4; ++j) {
        const int col = j * 256 + lane * 4;
        const float4 x4 = q ? w[j] : v[j];
        const float4 w4 = *(const float4*)(nw + col), s4 = *(const float4*)(sc + col), h4 = *(const float4*)(sh + col);
        half4 o;
        o[0] = (h16)(x4.x * rstd * w4.x * (1.f + s4.x) + h4.x);
        o[1] = (h16)(x4.y * rstd * w4.y * (1.f + s4.y) + h4.y);
        o[2] = (h16)(x4.z * rstd * w4.z * (1.f + s4.z) + h4.z);
        o[3] = (h16)(x4.w * rstd * w4.w * (1.f + s4.w) + h4.w);
        *(half4*)(H + (size_t)rr * DM + col) = o;
      }
    }
  }
}

template <int MODE>
__device__ void gemm_phase(const Params& p_, int layer, unsigned char* smem, int wv) {
  (void)p_;
  auto kp_ = __builtin_amdgcn_kernarg_segment_ptr();
  asm volatile("" : "+s"(kp_));
  const Params p = *(const Params*)kp_;
  const int bid = BID();
  const int tid = TID(wv), lane = tid & 63, wave = tid >> 6;
  const int wm = wave >> 1, wn = wave & 1;
  const int Mrows = MODE == 0 ? MTOT : (layer == 0 ? MTOT : MLAT);
  const int N = MODE == 0 ? DIN : DM;
  const int nM = Mrows / 256, nN = N / 128;
  const h16* Wt = (const h16*)(p.ws + (MODE == 0 ? OFF_WIN + (size_t)layer * SZ_WIN : OFF_WOUT + (size_t)layer * SZ_WOUT));
  const h16* Abase = (const h16*)(p.ws + OFF_H);
  h16* sA = (h16*)smem;
  h16* sB = sA + 2 * 256 * 80;
  const int lr = lane & 15, lq = lane >> 4;
  if (__builtin_amdgcn_readfirstlane(tid) >= 256) __builtin_amdgcn_s_setprio(1);
  const int G = gridDim.x;
  const int nx = (G % 8 == 0) ? 8 : 1, per = G / nx;
  const int xcd = bid % nx, slot = bid / nx;
  const int total = nM * nN, fullN = (nN / 4) * 4;
  for (int it = 0;; ++it) {
    const int idx = (it * nx + xcd) * per + slot;
    if (idx >= total) break;
    int tm, tn;
    if (idx < nM * fullN) { const int panel = idx / (nM * 4), r = idx % (nM * 4); tm = r >> 2; tn = panel * 4 + (r & 3); }
    else { const int r = idx - nM * fullN, wrem = nN - fullN; tm = r / wrem; tn = fullN + r % wrem; }
    const int m0 = tm * 256, n0 = tn * 128;
    f32x4 acc[4][4];
#pragma unroll
    for (int i = 0; i < 4; ++i)
#pragma unroll
      for (int j = 0; j < 4; ++j) acc[i][j] = f32x4{0.f, 0.f, 0.f, 0.f};
    half8 ra[2][4], rb[2][2];
    const int ldrow = tid >> 3, ldcol = (tid & 7) * 8;
    const h16* aptr0 = (MODE == 0) ? Abase + (size_t)(m0 + ldrow) * DM + ldcol : Abase + (size_t)(m0 + ldrow) * 512 + ldcol;
    const h16* bptr0 = Wt + (size_t)(n0 + ldrow) * DM + ldcol;
#define APTR(KT) ((MODE == 0) ? aptr0 + (KT) * 64 : aptr0 + ((KT) < 8 ? (size_t)0 : (size_t)MTOT * 512) + ((KT) & 7) * 64)
#define ASTR ((size_t)64 * (MODE == 0 ? DM : 512))
#define GLOAD_PART(SET, KT, PART) do { \
      if ((PART) < 2) { const h16* ap_ = APTR(KT); ra[SET][2 * (PART)] = *(const half8*)(ap_ + (2 * (PART)) * ASTR); ra[SET][2 * (PART) + 1] = *(const half8*)(ap_ + (2 * (PART) + 1) * ASTR); } \
      else { rb[SET][0] = *(const half8*)(bptr0 + (KT) * 64); rb[SET][1] = *(const half8*)(bptr0 + (size_t)64 * DM + (KT) * 64); } } while (0)
#define SSTORE_PART(SET, BUF, PART) do { \
      if ((PART) < 2) { *(half8*)(sA + (size_t)(BUF) * 256 * 80 + (ldrow + (2 * (PART)) * 64) * 80 + ldcol) = ra[SET][2 * (PART)]; \
                        *(half8*)(sA + (size_t)(BUF) * 256 * 80 + (ldrow + (2 * (PART) + 1) * 64) * 80 + ldcol) = ra[SET][2 * (PART) + 1]; } \
      else { *(half8*)(sB + (size_t)(BUF) * 128 * 80 + ldrow * 80 + ldcol) = rb[SET][0]; *(half8*)(sB + (size_t)(BUF) * 128 * 80 + (ldrow + 64) * 80 + ldcol) = rb[SET][1]; } } while (0)
#define GLOAD(SET, KT) do { GLOAD_PART(SET, KT, 0); GLOAD_PART(SET, KT, 1); GLOAD_PART(SET, KT, 2); } while (0)
#define SSTORE(SET, BUF) do { SSTORE_PART(SET, BUF, 0); SSTORE_PART(SET, BUF, 1); SSTORE_PART(SET, BUF, 2); } while (0)
#define MMA8(KK, J0) do { \
      _Pragma("unroll") for (int j_ = (J0); j_ < (J0) + 2; ++j_) \
        _Pragma("unroll") for (int i_ = 0; i_ < 4; ++i_) acc[i_][j_] = __builtin_amdgcn_mfma_f32_16x16x32_f16(bf[KK][j_], af[KK][i_], acc[i_][j_], 0, 0, 0); } while (0)
#define STEP(BUF, SET, NBUF, KNEXT) do { \
      const h16* a_s = sA + (size_t)(BUF) * 256 * 80 + (wm * 64 + lr) * 80 + lq * 8; \
      const h16* b_s = sB + (size_t)(BUF) * 128 * 80 + (wn * 64 + lr) * 80 + lq * 8; \
      half8 af[2][4], bf[2][4]; \
      _Pragma("unroll") for (int kk = 0; kk < 2; ++kk) { \
        bf[kk][0] = *(const half8*)(b_s + kk * 32); \
        _Pragma("unroll") for (int i_ = 0; i_ < 4; ++i_) af[kk][i_] = *(const half8*)(a_s + i_ * 16 * 80 + kk * 32); \
        _Pragma("unroll") for (int j_ = 1; j_ < 4; ++j_) bf[kk][j_] = *(const half8*)(b_s + j_ * 16 * 80 + kk * 32); \
      } \
      __builtin_amdgcn_sched_barrier(0); \
      MMA8(0, 0); __builtin_amdgcn_sched_barrier(0); \
      SSTORE_PART(SET, NBUF, 0); GLOAD_PART(SET, KNEXT, 0); __builtin_amdgcn_sched_barrier(0); \
      MMA8(0, 2); __builtin_amdgcn_sched_barrier(0); \
      SSTORE_PART(SET, NBUF, 1); GLOAD_PART(SET, KNEXT, 1); __builtin_amdgcn_sched_barrier(0); \
      MMA8(1, 0); __builtin_amdgcn_sched_barrier(0); \
      SSTORE_PART(SET, NBUF, 2); GLOAD_PART(SET, KNEXT, 2); __builtin_amdgcn_sched_barrier(0); \
      MMA8(1, 2); __builtin_amdgcn_sched_barrier(0); \
      } while (0)
    constexpr int NK = DM / 64;
    GLOAD(0, 0);
    GLOAD(1, 1);
    SSTORE(0, 0);
    GLOAD(0, 2);
    lds_barrier();
#pragma unroll 1
    for (int kt = 0; kt < NK; kt += 2) {
      const int k3 = kt + 3 < NK ? kt + 3 : NK - 1, k4 = kt + 4 < NK ? kt + 4 : NK - 1;
      STEP(0, 1, 1, k3);
      lds_barrier();
      STEP(1, 0, 0, k4);
      lds_barrier();
    }
#undef GLOAD
#undef SSTORE
#undef GLOAD_PART
#undef SSTORE_PART
#undef MMA8
#undef STEP
#undef APTR
#undef ASTR
    if (MODE == 0) {
      h16* P = (h16*)(p.ws + OFF_P);
      size_t secoff; int stride, coff;
      if (n0 < 2048) { secoff = (size_t)MTOT * 512 * (n0 >> 9); stride = 512; coff = n0 & 511; }
      else if (n0 < 3712) { secoff = SEC_RW; stride = DSHIFT; coff = n0 - 2048; }
      else { secoff = SEC_GW; stride = 512; coff = n0 - 3712; }
#pragma unroll
      for (int i = 0; i < 4; ++i) {
        const int m = m0 + wm * 64 + i * 16 + lr;
#pragma unroll
        for (int j = 0; j < 4; ++j) {
          const int nl = wn * 64 + j * 16 + lq * 4;
          half4 o;
          o[0] = (h16)acc[i][j][0]; o[1] = (h16)acc[i][j][1]; o[2] = (h16)acc[i][j][2]; o[3] = (h16)acc[i][j][3];
          *(half4*)(P + secoff + (size_t)m * stride + coff + nl) = o;
        }
      }
    } else {
      const float* mod = (const float*)(p.ws + OFF_MOD) + (size_t)layer * 9 * 3072;
#pragma unroll
      for (int i = 0; i < 4; ++i) {
        const int m = m0 + wm * 64 + i * 16 + lr;
        const int cond = m < MLAT ? (m >> 11) : 8;
        const float* xo = xrow_ptr(p, layer, m);
        float* xn = m < MLAT ? p.out + (size_t)m * DM : (float*)(p.ws + OFF_XC) + (size_t)(m - MLAT) * DM;
#pragma unroll
        for (int j = 0; j < 4; ++j) {
          const int n = n0 + wn * 64 + j * 16 + lq * 4;
          const float4 g = *(const float4*)(mod + cond * 3072 + 2048 + n);
          const float4 xv = *(const float4*)(xo + n);
          float4 o;
          o.x = xv.x + g.x * acc[i][j][0]; o.y = xv.y + g.y * acc[i][j][1];
          o.z = xv.z + g.z * acc[i][j][2]; o.w = xv.w + g.w * acc[i][j][3];
          *(float4*)(xn + n) = o;
        }
      }
    }
  }
  __builtin_amdgcn_s_setprio(0);
}

__device__ __forceinline__ int chunk_row0(int b, int u) { return u < 2 ? MLAT + b * CTXL + u * 128 : b * SEQ + (u - 2) * 128; }

__device__ __forceinline__ void load_rope(const h16* src, const float2* tab, int qd, bool rope, int t, float scale, float* lo, float* hi) {
  const int hsel = qd >> 1, f0 = (qd & 1) * 8;
  const half8 a = *(const half8*)(src + hsel * 32 + f0);
  const half8 b = *(const half8*)(src + hsel * 32 + 16 + f0);
  if (rope) {
    const int pos = hsel == 0 ? (t >> 6) : (t & 63);
    const float2* tb = tab + pos * 16 + f0;
#pragma unroll
    for (int f = 0; f < 8; ++f) {
      const float2 cs = tb[f];
      const float x1 = (float)a[f], x2 = (float)b[f];
      lo[f] = (x1 * cs.x - x2 * cs.y) * scale;
      hi[f] = (x1 * cs.y + x2 * cs.x) * scale;
    }
  } else {
#pragma unroll
    for (int f = 0; f < 8; ++f) { lo[f] = (float)a[f] * scale; hi[f] = (float)b[f] * scale; }
  }
}

__device__ __forceinline__ void rope_regs(const half8 a, const half8 b, const float2* tab, int qd, bool rope, int t, float scale, float* lo, float* hi) {
  const int hsel = qd >> 1, f0 = (qd & 1) * 8;
  if (rope) {
    const int pos = hsel == 0 ? (t >> 6) : (t & 63);
    const float2* tb = tab + pos * 16 + f0;
#pragma unroll
    for (int f = 0; f < 8; ++f) {
      const float2 cs = tb[f];
      const float x1 = (float)a[f], x2 = (float)b[f];
      lo[f] = (x1 * cs.x - x2 * cs.y) * scale;
      hi[f] = (x1 * cs.y + x2 * cs.x) * scale;
    }
  } else {
#pragma unroll
    for (int f = 0; f < 8; ++f) { lo[f] = (float)a[f] * scale; hi[f] = (float)b[f] * scale; }
  }
}

__device__ __forceinline__ half4 lds_tr_read(unsigned addr) {
  half4 r;
  asm volatile("ds_read_b64_tr_b16 %0, %1" : "=&v"(r) : "v"(addr) : "memory");
  return r;
}
__device__ __forceinline__ unsigned lds_addr_of(const void* p_) {
  return (unsigned)(unsigned long)(__attribute__((address_space(3))) const void*)p_;
}

__device__ void phase_ret_kv(const Params& p_, int layer, unsigned char* smem, int wv) {
  (void)p_;
  auto kp_ = __builtin_amdgcn_kernarg_segment_ptr();
  asm volatile("" : "+s"(kp_));
  const Params p = *(const Params*)kp_;
  const int bid = BID();
  const int tid = TID(wv), lane = tid & 63, wave = tid >> 6;
  const int lr = lane & 15, lq = lane >> 4;
  const h16* P = (const h16*)(p.ws + OFF_P);
  h16* KVT = (h16*)(p.ws + OFF_H) + (size_t)MTOT * 512;
  h16* Vr = (h16*)smem;
  h16* Kf = Vr + 128 * 72;
  h16* Kb = Kf + 128 * 72;
  half8 rk0, rk1, rv0, rv1;
  auto fetch = [&](int it_) {
    const int bh_ = it_ / 18, u_ = it_ % 18;
    const size_t row_ = (size_t)(chunk_row0(bh_ >> 3, u_) + (tid >> 2));
    const int qd_ = tid & 3, hh = bh_ & 7;
    const h16* ks_ = P + SEC_K + row_ * 512 + hh * 64 + (qd_ >> 1) * 32 + (qd_ & 1) * 8;
    rk0 = *(const half8*)ks_; rk1 = *(const half8*)(ks_ + 16);
    const h16* vs_ = P + SEC_V + row_ * 512 + hh * 64 + qd_ * 16;
    rv0 = *(const half8*)vs_; rv1 = *(const half8*)(vs_ + 8);
  };
  if (bid < 64 * 18) fetch(bid);
  for (int it = bid; it < 64 * 18; it += gridDim.x) {
    const int bh = it / 18, u = it % 18, b = bh >> 3, h = bh & 7;
    const int row0 = chunk_row0(b, u);
    const float lgf = p.ret_lg[(layer * 2 + 0) * 8 + h], lgb = p.ret_lg[(layer * 2 + 1) * 8 + h];
    {
      const int j = tid >> 2, qd = tid & 3;
      const int t = (u < 2) ? 0 : (u - 2) * 128 + j;
      float lo[8], hi[8];
      rope_regs(rk0, rk1, (const float2*)(p.ws + OFF_ROPE), qd, u >= 2, t, 0.125f, lo, hi);
      const float df = expf(lgf * (float)(127 - j)), db = expf(lgb * (float)j);
      const int d0 = (qd >> 1) * 32 + (qd & 1) * 8;
      half8 fl, fh, bl, bh8;
#pragma unroll
      for (int f = 0; f < 8; ++f) { fl[f] = (h16)(lo[f] * df); fh[f] = (h16)(hi[f] * df); bl[f] = (h16)(lo[f] * db); bh8[f] = (h16)(hi[f] * db); }
      *(half8*)(Kf + j * 72 + d0) = fl; *(half8*)(Kf + j * 72 + d0 + 16) = fh;
      *(half8*)(Kb + j * 72 + d0) = bl; *(half8*)(Kb + j * 72 + d0 + 16) = bh8;
      *(half8*)(Vr + j * 72 + qd * 16) = rv0;
      *(half8*)(Vr + j * 72 + qd * 16 + 8) = rv1;
    }
    __syncthreads();
    if (it + (int)gridDim.x < 64 * 18) fetch(it + gridDim.x);
    {
      const int dir = wave >> 2, ei = wave & 3;
      const unsigned lane_off = (unsigned)(((lq * 8 + (lr >> 2)) * 72 + 4 * (lr & 3)) * 2);
      const unsigned vbase = lds_addr_of(Vr) + lane_off + (unsigned)(ei * 16 * 2);
      const unsigned kbase = lds_addr_of(dir ? Kb : Kf) + lane_off;
      half4 va[4][2], kb[4][4][2];
#pragma unroll
      for (int ks = 0; ks < 4; ++ks) {
        va[ks][0] = lds_tr_read(vbase + ks * 32 * 72 * 2);
        va[ks][1] = lds_tr_read(vbase + ks * 32 * 72 * 2 + 4 * 72 * 2);
#pragma unroll
        for (int jd = 0; jd < 4; ++jd) {
          kb[ks][jd][0] = lds_tr_read(kbase + ks * 32 * 72 * 2 + jd * 16 * 2);
          kb[ks][jd][1] = lds_tr_read(kbase + ks * 32 * 72 * 2 + jd * 16 * 2 + 4 * 72 * 2);
        }
      }
      f32x4 acc[4];
#pragma unroll
      for (int jd = 0; jd < 4; ++jd) acc[jd] = f32x4{0.f, 0.f, 0.f, 0.f};
#pragma unroll
      for (int ks = 0; ks < 4; ++ks) {
        asm volatile("s_waitcnt lgkmcnt(0)"
                     : "+v"(va[ks][0]), "+v"(va[ks][1]), "+v"(kb[ks][0][0]), "+v"(kb[ks][0][1]), "+v"(kb[ks][1][0]), "+v"(kb[ks][1][1]),
                       "+v"(kb[ks][2][0]), "+v"(kb[ks][2][1]), "+v"(kb[ks][3][0]), "+v"(kb[ks][3][1])
                     :: "memory");
        const half8 vf = {va[ks][0][0], va[ks][0][1], va[ks][0][2], va[ks][0][3], va[ks][1][0], va[ks][1][1], va[ks][1][2], va[ks][1][3]};
#pragma unroll
        for (int jd = 0; jd < 4; ++jd) {
          const half8 kf = {kb[ks][jd][0][0], kb[ks][jd][0][1], kb[ks][jd][0][2], kb[ks][jd][0][3],
                            kb[ks][jd][1][0], kb[ks][jd][1][1], kb[ks][jd][1][2], kb[ks][jd][1][3]};
          acc[jd] = __builtin_amdgcn_mfma_f32_16x16x32_f16(kf, vf, acc[jd], 0, 0, 0);
        }
      }
      h16* dst = KVT + (((size_t)dir * 64 + bh) * 18 + u) * 4096;
#pragma unroll
      for (int jd = 0; jd < 4; ++jd) {
        half4 o4;
#pragma unroll
        for (int r = 0; r < 4; ++r) o4[r] = (h16)acc[jd][r];
        *(half4*)(dst + (ei * 16 + lr) * 64 + jd * 16 + lq * 4) = o4;
      }
    }
    __syncthreads();
  }
}

__device__ void phase_ret_prefix(const Params& p_, int layer, int wv) {
  (void)p_;
  auto kp_ = __builtin_amdgcn_kernarg_segment_ptr();
  asm volatile("" : "+s"(kp_));
  const Params p = *(const Params*)kp_;
  const int bid = BID();
  const int tid = TID(wv);
  h16* KVT = (h16*)(p.ws + OFF_H) + (size_t)MTOT * 512;
  for (int idx = bid * NTHR + tid; idx < 128 * 512; idx += gridDim.x * NTHR) {
    const int seq = idx >> 9, e8 = (idx & 511) * 8;
    const int dir = seq >> 6, h = seq & 7;
    const float cd = expf(p.ret_lg[(layer * 2 + dir) * 8 + h] * 128.f);
    h16* base = KVT + (size_t)seq * 18 * 4096 + e8;
    half8 kv[18];
#pragma unroll
    for (int pp = 0; pp < 18; ++pp) {
      const int uu = dir == 0 ? pp : (pp < 2 ? 1 - pp : 19 - pp);
      kv[pp] = *(const half8*)(base + (size_t)uu * 4096);
    }
    float a[8];
#pragma unroll
    for (int i = 0; i < 8; ++i) a[i] = 0.f;
#pragma unroll
    for (int pp = 0; pp < 18; ++pp) {
      const int uu = dir == 0 ? pp : (pp < 2 ? 1 - pp : 19 - pp);
      half8 o;
#pragma unroll
      for (int i = 0; i < 8; ++i) o[i] = (h16)a[i];
      *(half8*)(base + (size_t)uu * 4096) = o;
#pragma unroll
      for (int i = 0; i < 8; ++i) a[i] = a[i] * cd + (float)kv[pp][i];
    }
  }
}

__device__ void phase_ret_out(const Params& p_, int layer, unsigned char* smem, int wv) {
  (void)p_;
  auto kp_ = __builtin_amdgcn_kernarg_segment_ptr();
  asm volatile("" : "+s"(kp_));
  const Params p = *(const Params*)kp_;
  const int bid = BID();
  const int tid = TID(wv), lane = tid & 63, wave = tid >> 6;
  const int lr = lane & 15, lq = lane >> 4;
  const h16* P = (const h16*)(p.ws + OFF_P);
  const h16* KVT = (const h16*)(p.ws + OFF_H) + (size_t)MTOT * 512;
  h16* MIXret = (h16*)(p.ws + OFF_H);
  h16* Qs = (h16*)smem;
  h16* Ks = Qs + 128 * 80;
  h16* VT = Ks + 128 * 80;
  h16* SC = VT + 64 * 144;
  h16* SfT = SC + 128 * 144;
  h16* SbT = SfT + 64 * 80;
  const int u_lo = layer == 0 ? 0 : 2, nu = 18 - u_lo;
  for (int it = bid; it < 64 * nu; it += gridDim.x) {
    const int bh = it / nu, u = u_lo + it % nu, b = bh >> 3, h = bh & 7;
    const int row0 = chunk_row0(b, u);
    const float lgf = p.ret_lg[(layer * 2 + 0) * 8 + h], lgb = p.ret_lg[(layer * 2 + 1) * 8 + h];
    {
      const int j = tid >> 2, qd = tid & 3;
      const size_t row = (size_t)(row0 + j);
      const int t = (u < 2) ? 0 : (u - 2) * 128 + j;
      const int d0 = (qd >> 1) * 32 + (qd & 1) * 8;
      float lo[8], hi[8];
      load_rope(P + SEC_Q + row * 512 + h * 64, (const float2*)(p.ws + OFF_ROPE), qd, u >= 2, t, 1.f, lo, hi);
      half8 o0, o1;
#pragma unroll
      for (int f = 0; f < 8; ++f) { o0[f] = (h16)lo[f]; o1[f] = (h16)hi[f]; }
      *(half8*)(Qs + j * 80 + d0) = o0; *(half8*)(Qs + j * 80 + d0 + 16) = o1;
      load_rope(P + SEC_K + row * 512 + h * 64, (const float2*)(p.ws + OFF_ROPE), qd, u >= 2, t, 0.125f, lo, hi);
#pragma unroll
      for (int f = 0; f < 8; ++f) { o0[f] = (h16)lo[f]; o1[f] = (h16)hi[f]; }
      *(half8*)(Ks + j * 80 + d0) = o0; *(half8*)(Ks + j * 80 + d0 + 16) = o1;
      const h16* vs = P + SEC_V + row * 512 + h * 64 + qd * 16;
      const half8 v0 = *(const half8*)vs, v1 = *(const half8*)(vs + 8);
#pragma unroll
      for (int f = 0; f < 8; ++f) { VT[(qd * 16 + f) * 144 + j] = v0[f]; VT[(qd * 16 + 8 + f) * 144 + j] = v1[f]; }
    }
    {
      const int e = tid >> 3, d8 = (tid & 7) * 8;
      const half8 of = *(const half8*)(KVT + (((size_t)0 * 64 + bh) * 18 + u) * 4096 + e * 64 + d8);
      const half8 ob = *(const half8*)(KVT + (((size_t)1 * 64 + bh) * 18 + u) * 4096 + e * 64 + d8);
      *(half8*)(SfT + e * 80 + d8) = of;
      *(half8*)(SbT + e * 80 + d8) = ob;
    }
    __syncthreads();
    {
      const int i_loc = wave * 16 + lr;
      half8 qf[2];
      qf[0] = *(const half8*)(Qs + i_loc * 80 + lq * 8);
      qf[1] = *(const half8*)(Qs + i_loc * 80 + 32 + lq * 8);
      const float l2f = lgf * 1.44269504f, l2b = lgb * 1.44269504f;
#pragma unroll
      for (int js = 0; js < 8; ++js) {
        f32x4 s = f32x4{0.f, 0.f, 0.f, 0.f};
#pragma unroll
        for (int kk = 0; kk < 2; ++kk) {
          const half8 kf = *(const half8*)(Ks + (js * 16 + lr) * 80 + kk * 32 + lq * 8);
          s = __builtin_amdgcn_mfma_f32_16x16x32_f16(kf, qf[kk], s, 0, 0, 0);
        }
        half4 o;
#pragma unroll
        for (int r = 0; r < 4; ++r) {
          const int j = js * 16 + lq * 4 + r;
          const int rel = i_loc - j;
          const float m = rel > 0 ? exp2f(l2f * (float)rel) : (rel < 0 ? exp2f(l2b * (float)(-rel)) : 2.f);
          o[r] = (h16)(s[r] * m);
        }
        *(half4*)(SC + i_loc * 144 + js * 16 + lq * 4) = o;
      }
    }
    __syncthreads();
    {
      const int i_loc = wave * 16 + lr;
      f32x4 ai[4], xf[4], xb[4];
#pragma unroll
      for (int je = 0; je < 4; ++je) { ai[je] = f32x4{0.f, 0.f, 0.f, 0.f}; xf[je] = ai[je]; xb[je] = ai[je]; }
#pragma unroll
      for (int ks = 0; ks < 4; ++ks) {
        const half8 sf = *(const half8*)(SC + i_loc * 144 + ks * 32 + lq * 8);
#pragma unroll
        for (int je = 0; je < 4; ++je) {
          const half8 vf = *(const half8*)(VT + (je * 16 + lr) * 144 + ks * 32 + lq * 8);
          ai[je] = __builtin_amdgcn_mfma_f32_16x16x32_f16(vf, sf, ai[je], 0, 0, 0);
        }
      }
#pragma unroll
      for (int kk = 0; kk < 2; ++kk) {
        const half8 qf = *(const half8*)(Qs + i_loc * 80 + kk * 32 + lq * 8);
#pragma unroll
        for (int je = 0; je < 4; ++je) {
          const half8 s1 = *(const half8*)(SfT + (je * 16 + lr) * 80 + kk * 32 + lq * 8);
          const half8 s2 = *(const half8*)(SbT + (je * 16 + lr) * 80 + kk * 32 + lq * 8);
          xf[je] = __builtin_amdgcn_mfma_f32_16x16x32_f16(s1, qf, xf[je], 0, 0, 0);
          xb[je] = __builtin_amdgcn_mfma_f32_16x16x32_f16(s2, qf, xb[je], 0, 0, 0);
        }
      }
      const float df = expf(lgf * (float)(i_loc + 1)), db = expf(lgb * (float)(128 - i_loc));
      float o[4][4], ss = 0.f;
#pragma unroll
      for (int je = 0; je < 4; ++je)
#pragma unroll
        for (int r = 0; r < 4; ++r) { o[je][r] = ai[je][r] + df * xf[je][r] + db * xb[je][r]; ss += o[je][r] * o[je][r]; }
      ss += shx(ss, lane, 16);
      ss += shx(ss, lane, 32);
      const float rn = rsqrtf(ss * (1.f / 64.f) + NORM_EPS);
      const size_t row = (size_t)(row0 + i_loc);
#pragma unroll
      for (int je = 0; je < 4; ++je) {
        const int e = je * 16 + lq * 4;
        const half4 g = *(const half4*)(P + SEC_GR + row * 512 + h * 64 + e);
        const float4 nw = *(const float4*)(p.ret_nw + layer * 512 + h * 64 + e);
        half4 res;
        res[0] = (h16)(o[je][0] * rn * nw.x * silu_f((float)g[0]));
        res[1] = (h16)(o[je][1] * rn * nw.y * silu_f((float)g[1]));
        res[2] = (h16)(o[je][2] * rn * nw.z * silu_f((float)g[2]));
        res[3] = (h16)(o[je][3] * rn * nw.w * silu_f((float)g[3]));
        *(half4*)(MIXret + row * 512 + h * 64 + e) = res;
      }
    }
    __syncthreads();
  }
}

typedef float f32x2 __attribute__((ext_vector_type(2)));
__device__ __forceinline__ f32x2 pk_fma(f32x2 a, f32x2 b, f32x2 c) { return __builtin_elementwise_fma(a, b, c); }

constexpr int SC_BUF_FLOATS = 32 * 64 * 2 + 32 * 4 * 64;

struct ScanOps { f32x4 kp0, kp1, b0, b1, m0, m1, r0, r1; float v; };
__device__ __forceinline__ void scan_load(ScanOps& o, const float* bufp, int st, int kq, int vrow) {
  const float* fd = bufp + 4096 + st * 256 + kq * 8;
  o.kp0 = *(const f32x4*)(fd + 192); o.kp1 = *(const f32x4*)(fd + 196);
  o.b0 = *(const f32x4*)(fd + 64); o.b1 = *(const f32x4*)(fd + 68);
  o.m0 = *(const f32x4*)(fd + 128); o.m1 = *(const f32x4*)(fd + 132);
  const float* rp = bufp + st * 64 + kq * 8;
  o.r0 = *(const f32x4*)rp; o.r1 = *(const f32x4*)(rp + 4);
  o.v = bufp[2048 + st * 64 + vrow];
}

__device__ void phase_rwkv_scan(const Params& p_, int layer, unsigned char* smem, int wv) {
  (void)p_;
  auto kp_ = __builtin_amdgcn_kernarg_segment_ptr();
  asm volatile("" : "+s"(kp_));
  const Params p = *(const Params*)kp_;
  const int bid = BID();
  const int tid = TID(wv), lane = tid & 63, wave = tid >> 6;
  const int lr = lane & 15, lq = lane >> 4;
  const h16* Prw = (const h16*)(p.ws + OFF_P) + SEC_RW;
  h16* Y = (h16*)(p.ws + OFF_Y);
  float* bufs = (float*)smem;
  float* ck = bufs + 2 * SC_BUF_FLOATS;
  float* sws = ck + 32 * 64;
  h16* xw16 = (h16*)(sws + 3 * 5 * 64 + 8);
  h16* xa16 = xw16 + 32 * 80;
  h16* w2h = xa16 + 32 * 80;
  h16* a2h = w2h + 64 * 80;
  float* scon = (float*)(a2h + 64 * 80);
  for (int it = bid; it < 256; it += gridDim.x) {
    const int chain = it >> 1, rh = it & 1;
    const int b = chain >> 4, h = (chain >> 1) & 7, d = chain & 1;
    __syncthreads();
    for (int i = tid; i < 960; i += NTHR) {
      const int tap = i / 320, g = (i % 320) >> 6, c = i & 63;
      const int col = g < 3 ? g * 512 + h * 64 + c : 1536 + (g - 3) * 64 + c;
      ((h16*)sws)[i] = (h16)p.shift_w[((size_t)layer * 3 + tap) * DSHIFT + col];
    }
    if (tid < 8) ((h16*)sws)[960 + tid] = (h16)0.f;
    for (int i = tid; i < 4096; i += NTHR) {
      const int k = i >> 6, n = i & 63;
      w2h[n * 80 + k] = (h16)p.w2[(((size_t)layer * 2 + d) * 64 + k) * 512 + h * 64 + n];
      a2h[n * 80 + k] = (h16)p.a2[(((size_t)layer * 2 + d) * 64 + k) * 512 + h * 64 + n];
    }
    if (tid < 192) {
      const int w_ = tid >> 6, c = tid & 63;
      scon[tid] = w_ == 0 ? p.w0[(layer * 2 + d) * 512 + h * 64 + c] : (w_ == 1 ? p.a0[(layer * 2 + d) * 512 + h * 64 + c] : p.k_a[layer * 512 + h * 64 + c]);
    }
    __syncthreads();
    if (wave >= 4) {
      const int bw = wave - 4;
      const int st = bw * 8 + (lane >> 3), c8 = (lane & 7) * 8;
      const bool isA = (lr & 1) != 0;
      const int tokL = bw * 8 + (lr >> 1);
      const float4 kk0 = *(const float4*)(p.k_k + layer * 512 + h * 64 + c8);
      const float4 kk1 = *(const float4*)(p.k_k + layer * 512 + h * 64 + c8 + 4);
      half8 pf[5][3];
      auto prefetch = [&](int ci) {
        const bool isctx = ci < 8;
        const int lc = isctx ? ci : ci - 8;
        const int L = isctx ? CTXL : SEQ;
        const int rowbase = isctx ? MLAT + b * CTXL : b * SEQ;
        const int pos = lc * 32 + st;
        const int t = d ? L - 1 - pos : pos;
        const h16* rowp = Prw + (size_t)(rowbase + t) * DSHIFT + c8;
#pragma unroll
        for (int g = 0; g < 5; ++g) {
          const int col = (g < 3 ? g * 512 + h * 64 : 1536 + (g - 3) * 64);
          const h16* src = rowp + col;
          pf[g][1] = *(const half8*)src;
          pf[g][0] = *(const half8*)(src - (t > 0 ? DSHIFT : 0));
          pf[g][2] = *(const half8*)(src + (t < L - 1 ? DSHIFT : 0));
        }
      };
      auto build_conv = [&](float* bufp, int ci) {
        const bool isctx = ci < 8;
        const int pos_ = (isctx ? ci : ci - 8) * 32 + st;
        const int L_ = isctx ? CTXL : SEQ;
        const int t_ = d ? L_ - 1 - pos_ : pos_;
        const h16* swh = (const h16*)sws;
        const h16* swa = (t_ > 0) ? swh + c8 : swh + 960;
        const h16* swc = (t_ < L_ - 1) ? swh + 2 * 5 * 64 + c8 : swh + 960;
        const int gstr_a = (t_ > 0) ? 64 : 0, gstr_c = (t_ < L_ - 1) ? 64 : 0;
#pragma unroll
        for (int g = 0; g < 5; ++g) {
          const half8 wa = *(const half8*)(swa + g * gstr_a);
          const half8 wb = *(const half8*)(swh + (1 * 5 + g) * 64 + c8);
          const half8 wc = *(const half8*)(swc + g * gstr_c);
          const half8 oh = wa * pf[g][0] + wb * pf[g][1] + wc * pf[g][2];
          float o[8];
          if (g < 4) {
#pragma unroll
            for (int i = 0; i < 8; ++i) o[i] = (float)oh[i];
          }
          if (g < 3) {
            float* dst = (g == 0 ? bufp : (g == 1 ? ck : bufp + 2048)) + st * 64 + c8;
            *(float4*)dst = float4{o[0], o[1], o[2], o[3]};
            *(float4*)(dst + 4) = float4{o[4], o[5], o[6], o[7]};
            if (g == 1) {
              float kk[8] = {o[0] * kk0.x, o[1] * kk0.y, o[2] * kk0.z, o[3] * kk0.w, o[4] * kk1.x, o[5] * kk1.y, o[6] * kk1.z, o[7] * kk1.w};
              float ss = 0.f;
#pragma unroll
              for (int i = 0; i < 8; ++i) ss += kk[i] * kk[i];
              ss = reduce8(ss);
              const float inv = __builtin_amdgcn_rsqf(fmaxf(ss, 1e-24f));
              float* kd = bufp + 4096 + st * 256 + 192 + c8;
              *(float4*)kd = float4{kk[0] * inv, kk[1] * inv, kk[2] * inv, kk[3] * inv};
              *(float4*)(kd + 4) = float4{kk[4] * inv, kk[5] * inv, kk[6] * inv, kk[7] * inv};
            }
          } else {
            half8 ho;
            if (g == 3) {
#pragma unroll
              for (int i = 0; i < 8; ++i) ho[i] = (h16)(1.f - 2.f * __builtin_amdgcn_rcpf(1.f + __expf(2.f * o[i])));
            } else {
              ho = oh;
            }
            *(half8*)((g == 3 ? xw16 : xa16) + st * 80 + c8) = ho;
          }
        }
      };
      auto build_lora = [&](float* bufp) {
        half8 xwf[2], xaf[2];
#pragma unroll
        for (int kk = 0; kk < 2; ++kk) {
          xwf[kk] = *(const half8*)(xw16 + tokL * 80 + kk * 32 + lq * 8);
          xaf[kk] = *(const half8*)(xa16 + tokL * 80 + kk * 32 + lq * 8);
        }
        f32x4 aw[4], aa[4];
#pragma unroll
        for (int ns = 0; ns < 4; ++ns) {
          aw[ns] = f32x4{0.f, 0.f, 0.f, 0.f}; aa[ns] = aw[ns];
#pragma unroll
          for (int kk = 0; kk < 2; ++kk) {
            const half8 wf = *(const half8*)(w2h + (ns * 16 + lr) * 80 + kk * 32 + lq * 8);
            const half8 af = *(const half8*)(a2h + (ns * 16 + lr) * 80 + kk * 32 + lq * 8);
            aw[ns] = __builtin_amdgcn_mfma_f32_16x16x32_f16(wf, xwf[kk], aw[ns], 0, 0, 0);
            aa[ns] = __builtin_amdgcn_mfma_f32_16x16x32_f16(af, xaf[kk], aa[ns], 0, 0, 0);
          }
        }
        const bool hf = isA;
        const int tk = lr >> 1;
#pragma unroll
        for (int jj = 0; jj < 2; ++jj) {
          const int c = (hf ? 32 : 0) + jj * 16 + lq * 4;
          const f32x4 c0w = *(const f32x4*)(scon + c), c0a = *(const f32x4*)(scon + 64 + c), ka = *(const f32x4*)(scon + 128 + c);
          float sgw[4], sga[4], Lv[4];
#pragma unroll
          for (int r = 0; r < 4; ++r) {
            const float xw_ = c0w[r] + (hf ? aw[2 + jj][r] : aw[jj][r]);
            const float xa_ = c0a[r] + (hf ? aa[2 + jj][r] : aa[jj][r]);
            sgw[r] = __builtin_amdgcn_rcpf(1.f + __expf(-xw_));
            sga[r] = __builtin_amdgcn_rcpf(1.f + __expf(-xa_));
            float x = -0.60653066f * sgw[r];
            x += dppf<0x112>(x);
            x += dppf<0x114>(x);
            x += dppf<0x118>(x);
            Lv[r] = x;
          }
          float* fd = bufp + 4096 + tokL * 256 + c;
          float e[4], en[4], ep[4];
#pragma unroll
          for (int r = 0; r < 4; ++r) {
            e[r] = __expf(Lv[r]); en[r] = __builtin_amdgcn_rcpf(e[r]);
            const float pe = dppf<0x112>(e[r]);
            ep[r] = (tk == 0) ? 1.f : pe;
          }
          float* rp = bufp + tokL * 64 + c;
          const float4 rv = *(const float4*)rp;
          *(float4*)rp = float4{rv.x * e[0], rv.y * e[1], rv.z * e[2], rv.w * e[3]};
          const float4 kv = *(const float4*)(ck + tokL * 64 + c);
          const float4 kp = *(const float4*)(fd + 192);
          if (tk == 7) *(float4*)fd = float4{e[0], e[1], e[2], e[3]};
          *(float4*)(fd + 64) = float4{kp.x * sga[0] * en[0], kp.y * sga[1] * en[1], kp.z * sga[2] * en[2], kp.w * sga[3] * en[3]};
          *(float4*)(fd + 128) = float4{kv.x * (1.f + (sga[0] - 1.f) * ka[0]) * en[0], kv.y * (1.f + (sga[1] - 1.f) * ka[1]) * en[1],
                                        kv.z * (1.f + (sga[2] - 1.f) * ka[2]) * en[2], kv.w * (1.f + (sga[3] - 1.f) * ka[3]) * en[3]};
          *(float4*)(fd + 192) = float4{kp.x * ep[0], kp.y * ep[1], kp.z * ep[2], kp.w * ep[3]};
        }
      };
      prefetch(0);
      build_conv(bufs, 0);
      prefetch(1);
      build_lora(bufs);
      lds_barrier();
      for (int ci = 0; ci < 72; ++ci) {
        if (ci + 1 < 72) {
          float* bufp = bufs + ((ci + 1) & 1) * SC_BUF_FLOATS;
          build_conv(bufp, ci + 1);
          if (ci + 2 < 72) prefetch(ci + 2);
          build_lora(bufp);
        }
        lds_barrier();
      }
    } else {
      __builtin_amdgcn_s_setprio(0);
      const int kq = lane & 7, rsub = lane >> 3;
      const int vrow = rh * 32 + wave * 8 + rsub;
      f32x2 s0 = {0.f, 0.f}, s1 = s0, s2 = s0, s3 = s0;
      float ysel = 0.f;
      float yp[8];
      lds_barrier();
      for (int ci = 0; ci < 72; ++ci) {
        const bool isctx = ci < 8;
        const int lc = isctx ? ci : ci - 8;
        const int L = isctx ? CTXL : SEQ;
        const int rowbase = isctx ? MLAT + b * CTXL : b * SEQ;
        const float* bufp = bufs + (ci & 1) * SC_BUF_FLOATS;
        ScanOps cur, nxt;
        scan_load(cur, bufp, 0, kq, vrow);
#pragma unroll 1
        for (int s8 = 0; s8 < 32; s8 += 8) {
#pragma unroll
          for (int u = 0; u < 8; ++u) {
            const int st = s8 + u;
            scan_load(nxt, bufp, (st + 1) & 31, kq, vrow);
            f32x2 t2 = s0 * f32x2{cur.kp0[0], cur.kp0[1]};
            t2 = pk_fma(s1, f32x2{cur.kp0[2], cur.kp0[3]}, t2);
            t2 = pk_fma(s2, f32x2{cur.kp1[0], cur.kp1[1]}, t2);
            t2 = pk_fma(s3, f32x2{cur.kp1[2], cur.kp1[3]}, t2);
            const float sk = reduce8(t2[0] + t2[1]);
            const f32x2 nsk = {-sk, -sk}, vv = {cur.v, cur.v};
            s0 = pk_fma(vv, f32x2{cur.m0[0], cur.m0[1]}, pk_fma(nsk, f32x2{cur.b0[0], cur.b0[1]}, s0));
            s1 = pk_fma(vv, f32x2{cur.m0[2], cur.m0[3]}, pk_fma(nsk, f32x2{cur.b0[2], cur.b0[3]}, s1));
            s2 = pk_fma(vv, f32x2{cur.m1[0], cur.m1[1]}, pk_fma(nsk, f32x2{cur.b1[0], cur.b1[1]}, s2));
            s3 = pk_fma(vv, f32x2{cur.m1[2], cur.m1[3]}, pk_fma(nsk, f32x2{cur.b1[2], cur.b1[3]}, s3));
            f32x2 y2 = s0 * f32x2{cur.r0[0], cur.r0[1]};
            y2 = pk_fma(s1, f32x2{cur.r0[2], cur.r0[3]}, y2);
            y2 = pk_fma(s2, f32x2{cur.r1[0], cur.r1[1]}, y2);
            y2 = pk_fma(s3, f32x2{cur.r1[2], cur.r1[3]}, y2);
            yp[u] = y2[0] + y2[1];
            cur = nxt;
          }
          {
            const bool hiq = (kq & 4) != 0;
            float q4[4];
#pragma unroll
            for (int j = 0; j < 4; ++j) {
              const float keep = hiq ? yp[4 + j] : yp[j], send = hiq ? yp[j] : yp[4 + j];
              q4[j] = keep + dppf<0x141>(send);
            }
            const bool b0 = (kq & 1) != 0;
            float q2[2];
#pragma unroll
            for (int j = 0; j < 2; ++j) {
              const float keep = b0 ? q4[2 * j + 1] : q4[2 * j], send = b0 ? q4[2 * j] : q4[2 * j + 1];
              q2[j] = keep + dppf<0xB1>(send);
            }
            const bool b1 = (kq & 2) != 0;
            const float keep = b1 ? q2[1] : q2[0], send = b1 ? q2[0] : q2[1];
            ysel = keep + dppf<0x4E>(send);
          }
          {
            const float* gp = bufp + 4096 + (s8 + 7) * 256 + kq * 8;
            const f32x4 g0 = *(const f32x4*)gp, g1 = *(const f32x4*)(gp + 4);
            s0 = s0 * f32x2{g0[0], g0[1]}; s1 = s1 * f32x2{g0[2], g0[3]};
            s2 = s2 * f32x2{g1[0], g1[1]}; s3 = s3 * f32x2{g1[2], g1[3]};
            const int pos = lc * 32 + s8 + kq;
            const int t = d ? L - 1 - pos : pos;
            Y[((size_t)d * MTOT + rowbase + t) * 512 + h * 64 + vrow] = (h16)ysel;
          }
        }
        lds_barrier();
      }
      __builtin_amdgcn_s_setprio(0);
    }
  }
}

__device__ void phase_rwkv_readout(const Params& p_, int layer, int wv) {
  (void)p_;
  auto kp_ = __builtin_amdgcn_kernarg_segment_ptr();
  asm volatile("" : "+s"(kp_));
  const Params p = *(const Params*)kp_;
  const int bid = BID();
  const int tid_ = TID(wv); const int lane = tid_ & 63, wave = tid_ >> 6;
  const h16* P = (const h16*)(p.ws + OFF_P);
  const h16* Prw = P + SEC_RW;
  const h16* Y = (const h16*)(p.ws + OFF_Y);
  h16* MIXrw = (h16*)(p.ws + OFF_H) + (size_t)MTOT * 512;
  const int Mrows = layer == 0 ? MTOT : MLAT;
  const int head = lane >> 3, c0 = (lane & 7) * 8, ch = head * 64 + c0;
  float swr[3][3][8], rk[8], lw[8], lb[8];
  {
    const float* sw = p.shift_w + (size_t)layer * 3 * DSHIFT;
#pragma unroll
    for (int tap = 0; tap < 3; ++tap)
#pragma unroll
      for (int g = 0; g < 3; ++g)
#pragma unroll
        for (int i = 0; i < 8; ++i) swr[tap][g][i] = sw[tap * DSHIFT + g * 512 + ch + i];
#pragma unroll
    for (int i = 0; i < 8; ++i) { rk[i] = p.r_k[layer * 512 + ch + i]; lw[i] = p.ln_w[layer * 512 + ch + i]; lb[i] = p.ln_b[layer * 512 + ch + i]; }
  }
  const int nwv = gridDim.x * 8;
  for (int mb = bid * 8 + wave; mb < Mrows; mb += 2 * nwv) {
    half8 yf[2], yb[2], gw[2], pr[2][3][3];
    int tt[2], LL[2];
    bool ok[2];
#pragma unroll
    for (int q = 0; q < 2; ++q) {
      const int mq = mb + q * nwv;
      ok[q] = mq < Mrows;
      const int m = ok[q] ? mq : mb;
      const int t = m < MLAT ? (m & (SEQ - 1)) : ((m - MLAT) & (CTXL - 1));
      const int L = m < MLAT ? SEQ : CTXL;
      tt[q] = t; LL[q] = L;
      yf[q] = *(const half8*)(Y + (size_t)m * 512 + ch);
      yb[q] = *(const half8*)(Y + ((size_t)MTOT + m) * 512 + ch);
      gw[q] = *(const half8*)(P + SEC_GW + (size_t)m * 512 + ch);
#pragma unroll
      for (int g = 0; g < 3; ++g) {
        const h16* src = Prw + (size_t)m * DSHIFT + g * 512 + ch;
        pr[q][g][1] = *(const half8*)src;
        pr[q][g][0] = *(const half8*)(src - (t > 0 ? DSHIFT : 0));
        pr[q][g][2] = *(const half8*)(src + (t < L - 1 ? DSHIFT : 0));
      }
    }
#pragma unroll
    for (int q = 0; q < 2; ++q) {
      if (!ok[q]) break;
      const int m = mb + q * nwv;
      const float m0 = tt[q] > 0 ? 1.f : 0.f, m2 = tt[q] < LL[q] - 1 ? 1.f : 0.f;
      float y[8], sum = 0.f;
#pragma unroll
      for (int i = 0; i < 8; ++i) { y[i] = (float)yf[q][i] + (float)yb[q][i]; sum += y[i]; }
      const float mu = reduce8(sum) * (1.f / 64.f);
      float vs = 0.f;
#pragma unroll
      for (int i = 0; i < 8; ++i) { y[i] -= mu; vs += y[i] * y[i]; }
      const float rstd = rsqrtf(reduce8(vs) * (1.f / 64.f) + GN_EPS);
      float cv[3][8];
#pragma unroll
      for (int g = 0; g < 3; ++g)
#pragma unroll
        for (int i = 0; i < 8; ++i)
          cv[g][i] = swr[0][g][i] * m0 * (float)pr[q][g][0][i] + swr[1][g][i] * (float)pr[q][g][1][i] + swr[2][g][i] * m2 * (float)pr[q][g][2][i];
      float dot = 0.f;
#pragma unroll
      for (int i = 0; i < 8; ++i) dot += cv[0][i] * cv[1][i] * rk[i];
      dot = reduce8(dot);
      half8 o;
#pragma unroll
      for (int i = 0; i < 8; ++i) {
        const float val = y[i] * rstd * lw[i] + lb[i] + dot * cv[2][i];
        o[i] = (h16)(val * silu_f((float)gw[q][i]));
      }
      *(half8*)(MIXrw + (size_t)m * 512 + ch) = o;
    }
  }
}

__device__ void phase_final(const Params& p_, int wv) {
  (void)p_;
  auto kp_ = __builtin_amdgcn_kernarg_segment_ptr();
  asm volatile("" : "+s"(kp_));
  const Params p = *(const Params*)kp_;
  const int bid = BID();
  const int tid_ = TID(wv); const int lane = tid_ & 63, wave = tid_ >> 6;
  const int nwv = gridDim.x * 8;
  for (int row = bid * 8 + wave; row < MLAT; row += 2 * nwv) {
    const int row2 = row + nwv;
    const bool has2 = row2 < MLAT;
    float* xr = p.out + (size_t)row * DM;
    float* xr2 = p.out + (size_t)(has2 ? row2 : row) * DM;
    float4 v[4], w[4];
    float ss = 0.f, ss2 = 0.f;
#pragma unroll
    for (int j = 0; j < 4; ++j) { v[j] = *(const float4*)(xr + j * 256 + lane * 4); w[j] = *(const float4*)(xr2 + j * 256 + lane * 4); }
#pragma unroll
    for (int j = 0; j < 4; ++j) {
      ss += v[j].x * v[j].x + v[j].y * v[j].y + v[j].z * v[j].z + v[j].w * v[j].w;
      ss2 += w[j].x * w[j].x + w[j].y * w[j].y + w[j].z * w[j].z + w[j].w * w[j].w;
    }
    ss = wave_sum(ss, lane);
    ss2 = wave_sum(ss2, lane);
    const float rstd = rsqrtf(ss * (1.f / DM) + NORM_EPS), rstd2 = rsqrtf(ss2 * (1.f / DM) + NORM_EPS);
#pragma unroll
    for (int j = 0; j < 4; ++j) {
      const int col = j * 256 + lane * 4;
      const float4 w4 = *(const float4*)(p.fnw + col);
      float4 o;
      o.x = v[j].x * rstd * w4.x; o.y = v[j].y * rstd * w4.y; o.z = v[j].z * rstd * w4.z; o.w = v[j].w * rstd * w4.w;
      *(float4*)(xr + col) = o;
      if (has2) {
        float4 o2;
        o2.x = w[j].x * rstd2 * w4.x; o2.y = w[j].y * rstd2 * w4.y; o2.z = w[j].z * rstd2 * w4.z; o2.w = w[j].w * rstd2 * w4.w;
        *(float4*)(xr2 + col) = o2;
      }
    }
  }
}

#define XB_TMO      128
#define XB_XCNT(j)  (256  + 64 * (j))
#define XB_XSUB(j)  (1280 + 64 * (j))
#define XB_XGEN(j)  (2304 + 64 * (j))
#define XB_TOP      3328
#define XB_TOPGEN   3392
#define XCD_BAR_WORDS 3456
#define XB_SPIN_CAP (1u << 18)
#define LAS __attribute__((address_space(3)))
__device__ __forceinline__ unsigned xb_ld(unsigned* p)              { return __hip_atomic_load(p, __ATOMIC_RELAXED, __HIP_MEMORY_SCOPE_AGENT); }
__device__ __forceinline__ unsigned xb_add(unsigned* p, unsigned v) { return __hip_atomic_fetch_add(p, v, __ATOMIC_RELAXED, __HIP_MEMORY_SCOPE_AGENT); }
__device__ __forceinline__ unsigned xb_xcc_id() { return (unsigned)__builtin_amdgcn_s_getreg((3 << 11) | 20) & 0xFu; }
#define XB_SPIN(cond, bar) do { unsigned _sp = 0; while (cond) { __builtin_amdgcn_s_sleep(1); \
    if ((++_sp & 255u) == 0u) { if (xb_ld(&(bar)[XB_TMO])) break; if (_sp > XB_SPIN_CAP) { atomicAdd(&(bar)[XB_TMO], 1u); break; } } } } while (0)
struct XcdBarrier { unsigned* bar; unsigned x; volatile LAS unsigned* st; int wv; };
__device__ __forceinline__ XcdBarrier xcd_barrier_post(unsigned* bar, volatile LAS unsigned* st, int wv) {
    XcdBarrier b; b.bar = bar; b.x = xb_xcc_id(); b.st = st; b.wv = wv;
    if (TID(wv) == 0) (void)xb_add(&bar[XB_XCNT(b.x)], 1u);
    return b;
}
__device__ __forceinline__ void xcd_barrier_complete(unsigned* bar, unsigned x, unsigned& nloc, unsigned& nx) {
    const unsigned G = gridDim.x * gridDim.y * gridDim.z;
    unsigned sum, cnt, mine, sp = 0u;
    for (;;) {
        sum = 0u; cnt = 0u; mine = 0u;
#pragma unroll
        for (unsigned j = 0; j < 16; ++j) { const unsigned c = xb_ld(&bar[XB_XCNT(j)]); sum += c; cnt += (c > 0u) ? 1u : 0u; mine = (j == x) ? c : mine; }
        if (sum == G) break;
        __builtin_amdgcn_s_sleep(1);
        if ((++sp & 255u) == 0u) { if (xb_ld(&bar[XB_TMO])) break; if (sp > XB_SPIN_CAP) { atomicAdd(&bar[XB_TMO], 1u); break; } }
    }
    nloc = mine > 0u ? mine : 1u; nx = cnt > 0u ? cnt : 1u;
}
__device__ __forceinline__ void xcd_barrier(const XcdBarrier& b) {
    const int wv = b.wv;
    asm volatile("s_waitcnt vmcnt(0)" ::: "memory");
    __syncthreads();
    if (TID(wv) == 0) {
        unsigned* bar = b.bar;
        __builtin_amdgcn_s_waitcnt(0);
        unsigned nloc = b.st[0], nx = b.st[1];
        if (nloc == 0u) { xcd_barrier_complete(bar, b.x, nloc, nx); b.st[0] = nloc; b.st[1] = nx; }
        const unsigned old = xb_add(&bar[XB_XSUB(b.x)], 1u);
        const unsigned gen = old / nloc;
        if (old + 1u == (gen + 1u) * nloc) {
            __builtin_amdgcn_fence(__ATOMIC_RELEASE, "agent");
            asm volatile("s_waitcnt vmcnt(0)" ::: "memory");
            const unsigned og = xb_add(&bar[XB_TOP], 1u);
            const unsigned tg = og / nx;
            if (og + 1u == (tg + 1u) * nx) xb_add(&bar[XB_TOPGEN], 1u);
            else XB_SPIN(xb_ld(&bar[XB_TOPGEN]) == tg, bar);
            __builtin_amdgcn_fence(__ATOMIC_ACQUIRE, "agent");
            xb_add(&bar[XB_XGEN(b.x)], 1u);
            asm volatile("s_waitcnt vmcnt(0)" ::: "memory");
        } else {
            XB_SPIN(xb_ld(&bar[XB_XGEN(b.x)]) == gen, bar);
            __builtin_amdgcn_fence(__ATOMIC_ACQUIRE, "agent");
            asm volatile("s_waitcnt vmcnt(0)" ::: "memory");
        }
    }
    __syncthreads();
}

__global__ void __launch_bounds__(NTHR) fwd_megakernel(Params p) {
  __shared__ __attribute__((aligned(16))) unsigned char smem[SMEM_BYTES];
  cg::grid_group grid = cg::this_grid();
  const int wv = __builtin_amdgcn_readfirstlane((int)threadIdx.x >> 6);
  __shared__ uint4 xb_words;
  if (TID(wv) == 0) xb_words = make_uint4(0u, 0u, 0u, 0u);
  __syncthreads();
  (void)xcd_barrier_post((unsigned*)(p.ws + OFF_BAR), (volatile LAS unsigned*)&xb_words, wv);
#define XBAR() do { XcdBarrier xb_; xb_.bar = (unsigned*)(p.ws + OFF_BAR); xb_.x = xb_xcc_id(); xb_.st = (volatile LAS unsigned*)&xb_words; xb_.wv = wv; xcd_barrier(xb_); } while (0)
#ifndef SK_A
  phase_adaln(p, smem, wv);
#endif
  if (p.ws == nullptr) grid.sync();
  XBAR();
  for (int layer = 0; layer < 2; ++layer) {
#ifndef SK_B
    phase_norm(p, layer, wv);
#endif
    XBAR();
#ifndef SK_C
    gemm_phase<0>(p, layer, smem, wv);
#endif
#ifdef DBL_C
    __syncthreads();
    gemm_phase<0>(p, layer, smem, wv);
#endif
    XBAR();
#ifndef SK_D
    phase_ret_kv(p, layer, smem, wv);
#endif
#ifdef DBL_D
    phase_ret_kv(p, layer, smem, wv);
#endif
    XBAR();
    phase_ret_prefix(p, layer, wv);
    XBAR();
#ifndef SK_E1
    phase_ret_out(p, layer, smem, wv);
#endif
#ifdef DBL_E1
    phase_ret_out(p, layer, smem, wv);
#endif
#ifndef SK_E2
    phase_rwkv_scan(p, layer, smem, wv);
#endif
#ifdef DBL_E2
    phase_rwkv_scan(p, layer, smem, wv);
#endif
    XBAR();
#ifndef SK_F
    phase_rwkv_readout(p, layer, wv);
#endif
#ifdef DBL_F
    phase_rwkv_readout(p, layer, wv);
#endif
    XBAR();
#ifndef SK_G
    gemm_phase<1>(p, layer, smem, wv);
#endif
    XBAR();
  }
  phase_final(p, wv);
}

extern "C" void kernel_launch(void* const* d_in, const int* in_sizes, int n_in, void* d_out, int out_size, void* d_ws,
                              size_t ws_size, hipStream_t stream) {
  static int grid_blocks = 0;
  if (!grid_blocks) {
    int dev = 0, cus = 0, per_cu = 0;
    hipGetDevice(&dev);
    hipDeviceGetAttribute(&cus, hipDeviceAttributeMultiprocessorCount, dev);
    hipOccupancyMaxActiveBlocksPerMultiprocessor(&per_cu, fwd_megakernel, NTHR, 0);
    if (per_cu < 1) per_cu = 1;
    grid_blocks = cus * per_cu;
    if (ws_size < WS_END) fprintf(stderr, "kernel_launch: workspace too small: %zu < %zu\n", ws_size, (size_t)WS_END);
  }
  Params p{};
  const float** pp = (const float**)&p;
  for (int i = 0; i < 22; ++i) pp[i] = (const float*)d_in[i];
  p.out = (float*)d_out;
  p.ws = (unsigned char*)d_ws;
  (void)hipMemsetAsync((unsigned char*)d_ws + OFF_BAR, 0, SZ_BAR, stream);
  void* args[] = {&p};
  hipError_t e = hipLaunchCooperativeKernel((void*)fwd_megakernel, dim3(grid_blocks), dim3(NTHR), args, 0, stream);
  if (e != hipSuccess) fprintf(stderr, "cooperative launch failed: %s (grid %d)\n", hipGetErrorString(e), grid_blocks);
}
```

```cpp
#include <hip/hip_runtime.h>
#include <hip/hip_fp16.h>
#include <hip/hip_cooperative_groups.h>
#include <cstdio>
namespace cg = cooperative_groups;

typedef _Float16 h16;
typedef _Float16 half8 __attribute__((ext_vector_type(8)));
typedef _Float16 half4 __attribute__((ext_vector_type(4)));
typedef float f32x4 __attribute__((ext_vector_type(4)));

constexpr int NB = 8, SEQ = 2048, CTXL = 256, DM = 1024;
constexpr int MLAT = NB * SEQ, MCTX = NB * CTXL, MTOT = MLAT + MCTX;
constexpr int DIN = 4224, HD = 64, DSHIFT = 1664;
constexpr int NTHR = 512;
constexpr float NORM_EPS = 1e-6f, GN_EPS = 64e-5f;

constexpr size_t OFF_P = 0;
constexpr size_t SZ_P = (size_t)MTOT * DIN * 2;
constexpr size_t OFF_H = OFF_P + SZ_P;
constexpr size_t SZ_H = (size_t)MTOT * DM * 2;
constexpr size_t OFF_Y = OFF_H + SZ_H;
constexpr size_t SZ_Y = (size_t)2 * MTOT * 512 * 2;
constexpr size_t OFF_XC = OFF_Y + SZ_Y;
constexpr size_t SZ_XC = (size_t)MCTX * DM * 4;
constexpr size_t OFF_WIN = OFF_XC + SZ_XC;
constexpr size_t SZ_WIN = (size_t)DIN * DM * 2;
constexpr size_t OFF_WOUT = OFF_WIN + 2 * SZ_WIN;
constexpr size_t SZ_WOUT = (size_t)DM * DM * 2;
constexpr size_t OFF_MOD = OFF_WOUT + 2 * SZ_WOUT;
constexpr size_t SZ_MOD = (size_t)2 * 9 * 3072 * 4;
constexpr size_t OFF_ROPE = OFF_MOD + SZ_MOD;
constexpr size_t SZ_ROPE = 64 * 16 * 2 * 4;
constexpr size_t OFF_BAR = OFF_ROPE + SZ_ROPE;
constexpr size_t SZ_BAR = 3456 * 4;
constexpr size_t WS_END = OFF_BAR + SZ_BAR;

constexpr size_t SEC_Q = 0, SEC_K = (size_t)MTOT * 512, SEC_V = (size_t)MTOT * 1024, SEC_GR = (size_t)MTOT * 1536,
                 SEC_RW = (size_t)MTOT * 2048, SEC_GW = (size_t)MTOT * 3712;

constexpr int SMEM_BYTES = 143360;

struct Params {
  const float *x, *c, *ctx, *c_ctx, *norm_w, *w_mod, *b_mod, *w_in, *ret_lg, *ret_nw, *shift_w, *w0, *w2, *a0, *a2,
      *k_k, *k_a, *r_k, *ln_w, *ln_b, *w_out, *fnw;
  float* out;
  unsigned char* ws;
};

__device__ __forceinline__ int TID(int w) {
  int t;
  asm volatile("v_mbcnt_lo_u32_b32 %0, -1, 0\n\tv_mbcnt_hi_u32_b32 %0, -1, %0\n\tv_lshl_or_b32 %0, %1, 6, %0" : "=&v"(t) : "s"(w));
  return t;
}
__device__ __forceinline__ int BID() { int t; asm volatile("s_mov_b32 %0, %1" : "=s"(t) : "s"((int)blockIdx.x)); return t; }

__device__ __forceinline__ float shx(float v, int lane, int m) {
  return __builtin_bit_cast(float, __builtin_amdgcn_ds_bpermute((lane ^ m) << 2, __builtin_bit_cast(int, v)));
}
__device__ __forceinline__ float wave_sum(float v, int lane) {
#pragma unroll
  for (int o = 1; o < 64; o <<= 1) v += shx(v, lane, o);
  return v;
}
template <int CTRL>
__device__ __forceinline__ float dppf(float x) {
  return __builtin_bit_cast(float, __builtin_amdgcn_update_dpp(0, __builtin_bit_cast(int, x), CTRL, 0xF, 0xF, true));
}
__device__ __forceinline__ float reduce8(float x) {
  x += dppf<0xB1>(x);
  x += dppf<0x4E>(x);
  x += dppf<0x141>(x);
  return x;
}
__device__ __forceinline__ float reduce16(float x) {
  x = reduce8(x);
  x += dppf<0x140>(x);
  return x;
}
__device__ __forceinline__ void lds_barrier() { asm volatile("s_waitcnt lgkmcnt(0)" ::: "memory"); __builtin_amdgcn_s_barrier(); asm volatile("" ::: "memory"); }
__device__ __forceinline__ float silu_f(float x) { return x / (1.f + expf(-x)); }

__device__ void transpose_item(const float* W, int N, h16* WT, int K, int item, float* tile, int wv) {
  const int tid = TID(wv);
  const int nblk = N / 64, kb = item / nblk, nbk = item % nblk, k0 = kb * 64, n0 = nbk * 64;
#pragma unroll
  for (int i = 0; i < 2; ++i) {
    const int r = (tid >> 4) + i * 32, c4 = (tid & 15) * 4;
    const float4 v = *(const float4*)(W + (size_t)(k0 + r) * N + n0 + c4);
    tile[r * 65 + c4 + 0] = v.x; tile[r * 65 + c4 + 1] = v.y; tile[r * 65 + c4 + 2] = v.z; tile[r * 65 + c4 + 3] = v.w;
  }
  __syncthreads();
  {
    const int n = tid >> 3, k8 = (tid & 7) * 8;
    half8 o;
#pragma unroll
    for (int i = 0; i < 8; ++i) o[i] = (h16)tile[(k8 + i) * 65 + n];
    *(half8*)(WT + (size_t)(n0 + n) * K + k0 + k8) = o;
  }
  __syncthreads();
}
__device__ void convert_weights(const Params& p, int blk, int nblk, unsigned char* smem, int wv) {
  constexpr int I_IN = (DM / 64) * (DIN / 64), I_OUT = (DM / 64) * (DM / 64), I_L = I_IN + I_OUT;
  float* tile = (float*)smem;
  for (int it = blk; it < 2 * I_L; it += nblk) {
    const int layer = it / I_L, r = it % I_L;
    if (r < I_IN) transpose_item(p.w_in + (size_t)layer * DM * DIN, DIN, (h16*)(p.ws + OFF_WIN + (size_t)layer * SZ_WIN), DM, r, tile, wv);
    else transpose_item(p.w_out + (size_t)layer * DM * DM, DM, (h16*)(p.ws + OFF_WOUT + (size_t)layer * SZ_WOUT), DM, r - I_IN, tile, wv);
  }
}

__device__ void phase_adaln(const Params& p_, unsigned char* smem, int wv) {
  (void)p_;
  auto kp_ = __builtin_amdgcn_kernarg_segment_ptr();
  asm volatile("" : "+s"(kp_));
  const Params p = *(const Params*)kp_;
  const int bid = BID();
  const int tid = TID(wv);
  float* scond = (float*)smem;
  float* red = scond + 9 * 1024;
  float* mod = (float*)(p.ws + OFF_MOD);
  const int nblocks = gridDim.x;
  if (bid == nblocks - 1) {
    float2* tab = (float2*)(p.ws + OFF_ROPE);
    for (int i = tid; i < 1024; i += NTHR) {
      const int pos = i >> 4, f = i & 15;
      const float inv = powf(10000.f, -(float)f * (1.f / 16.f));
      float sn, cs;
      sincosf((float)pos * inv, &sn, &cs);
      tab[i] = float2{cs, sn};
    }
  }
  if (bid < 96) {
    for (int i = tid; i < 9 * 1024; i += NTHR) {
      const int ci = i >> 10, k = i & 1023;
      const float v = ci < 8 ? p.c[ci * 1024 + k] : p.c_ctx[k];
      scond[i] = silu_f(v);
    }
    __syncthreads();
    for (int it = bid; it < 96; it += nblocks) {
      const int l = it / 48, nb = it % 48;
      const int kg = tid >> 6, nl = tid & 63, n = nb * 64 + nl;
      const float* wm = p.w_mod + (size_t)l * DM * 3072 + n;
      float acc[9];
#pragma unroll
      for (int i = 0; i < 9; ++i) acc[i] = 0.f;
#pragma unroll 4
      for (int k = kg * 128; k < kg * 128 + 128; ++k) {
        const float wv = wm[(size_t)k * 3072];
#pragma unroll
        for (int i = 0; i < 9; ++i) acc[i] += scond[i * 1024 + k] * wv;
      }
#pragma unroll
      for (int i = 0; i < 9; ++i) red[(kg * 9 + i) * 64 + nl] = acc[i];
      __syncthreads();
      for (int idx = tid; idx < 576; idx += NTHR) {
        const int i = idx >> 6, nn = idx & 63;
        float s = p.b_mod[l * 3072 + nb * 64 + nn];
#pragma unroll
        for (int g = 0; g < 8; ++g) s += red[(g * 9 + i) * 64 + nn];
        mod[((size_t)l * 9 + i) * 3072 + nb * 64 + nn] = s;
      }
      __syncthreads();
    }
    if (nblocks <= 96) convert_weights(p, bid, nblocks, smem, wv);
  } else {
    convert_weights(p, bid - 96, nblocks - 96, smem, wv);
  }
}

__device__ __forceinline__ const float* xrow_ptr(const Params& p, int layer, int row) {
  if (layer == 0) return row < MLAT ? p.x + (size_t)row * DM : p.ctx + (size_t)(row - MLAT) * DM;
  return row < MLAT ? p.out + (size_t)row * DM : (const float*)(p.ws + OFF_XC) + (size_t)(row - MLAT) * DM;
}
__device__ void phase_norm(const Params& p_, int layer, int wv) {
  (void)p_;
  auto kp_ = __builtin_amdgcn_kernarg_segment_ptr();
  asm volatile("" : "+s"(kp_));
  const Params p = *(const Params*)kp_;
  const int bid = BID();
  const int tid_ = TID(wv); const int lane = tid_ & 63, wave = tid_ >> 6;
  const float* mod = (const float*)(p.ws + OFF_MOD) + (size_t)layer * 9 * 3072;
  h16* H = (h16*)(p.ws + OFF_H);
  const float* nw = p.norm_w + layer * DM;
  const int nwv = gridDim.x * 8;
  for (int row = bid * 8 + wave; row < MTOT; row += 2 * nwv) {
    const int row2 = row + nwv;
    const bool has2 = row2 < MTOT;
    const float* xr = xrow_ptr(p, layer, row);
    const float* xr2 = xrow_ptr(p, layer, has2 ? row2 : row);
    float4 v[4], w[4];
    float ss = 0.f, ss2 = 0.f;
#pragma unroll
    for (int j = 0; j < 4; ++j) { v[j] = *(const float4*)(xr + j * 256 + lane * 4); w[j] = *(const float4*)(xr2 + j * 256 + lane * 4); }
#pragma unroll
    for (int j = 0; j < 4; ++j) {
      ss += v[j].x * v[j].x + v[j].y * v[j].y + v[j].z * v[j].z + v[j].w * v[j].w;
      ss2 += w[j].x * w[j].x + w[j].y * w[j].y + w[j].z * w[j].z + w[j].w * w[j].w;
    }
    ss = wave_sum(ss, lane);
    ss2 = wave_sum(ss2, lane);
#pragma unroll
    for (int q = 0; q < 2; ++q) {
      if (q == 1 && !has2) break;
      const int rr = q ? row2 : row;
      const float rstd = rsqrtf((q ? ss2 : ss) * (1.f / DM) + NORM_EPS);
      const int cond = rr < MLAT ? (rr >> 11) : 8;
      const float* sh = mod + cond * 3072;
      const float* sc = sh + 1024;
#pragma unroll
      for (int j = 0; j < 4; ++j) {
        const int col = j * 256 + lane * 4;
        const float4 x4 = q ? w[j] : v[j];
        const float4 w4 = *(const float4*)(nw + col), s4 = *(const float4*)(sc + col), h4 = *(const float4*)(sh + col);
        half4 o;
        o[0] = (h16)(x4.x * rstd * w4.x * (1.f + s4.x) + h4.x);
        o[1] = (h16)(x4.y * rstd * w4.y * (1.f + s4.y) + h4.y);
        o[2] = (h16)(x4.z * rstd * w4.z * (1.f + s4.z) + h4.z);
        o[3] = (h16)(x4.w * rstd * w4.w * (1.f + s4.w) + h4.w);
        *(half4*)(H + (size_t)rr * DM + col) = o;
      }
    }
  }
}

template <int MODE>
__device__ void gemm_phase(const Params& p_, int layer, unsigned char* smem, int wv) {
  (void)p_;
  auto kp_ = __builtin_amdgcn_kernarg_segment_ptr();
  asm volatile("" : "+s"(kp_));
  const Params p = *(const Params*)kp_;
  const int bid = BID();
  const int tid = TID(wv), lane = tid & 63, wave = tid >> 6;
  const int wm = wave >> 1, wn = wave & 1;
  const int Mrows = MODE == 0 ? MTOT : (layer == 0 ? MTOT : MLAT);
  const int N = MODE == 0 ? DIN : DM;
  const int nM = Mrows / 256, nN = N / 128;
  const h16* Wt = (const h16*)(p.ws + (MODE == 0 ? OFF_WIN + (size_t)layer * SZ_WIN : OFF_WOUT + (size_t)layer * SZ_WOUT));
  const h16* Abase = (const h16*)(p.ws + OFF_H);
  h16* sA = (h16*)smem;
  h16* sB = sA + 2 * 256 * 80;
  const int lr = lane & 15, lq = lane >> 4;
  if (__builtin_amdgcn_readfirstlane(tid) >= 256) __builtin_amdgcn_s_setprio(1);
  const int G = gridDim.x;
  const int nx = (G % 8 == 0) ? 8 : 1, per = G / nx;
  const int xcd = bid % nx, slot = bid / nx;
  const int total = nM * nN, fullN = (nN / 4) * 4;
  for (int it = 0;; ++it) {
    const int idx = (it * nx + xcd) * per + slot;
    if (idx >= total) break;
    int tm, tn;
    if (idx < nM * fullN) { const int panel = idx / (nM * 4), r = idx % (nM * 4); tm = r >> 2; tn = panel * 4 + (r & 3); }
    else { const int r = idx - nM * fullN, wrem = nN - fullN; tm = r / wrem; tn = fullN + r % wrem; }
    const int m0 = tm * 256, n0 = tn * 128;
    f32x4 acc[4][4];
#pragma unroll
    for (int i = 0; i < 4; ++i)
#pragma unroll
      for (int j = 0; j < 4; ++j) acc[i][j] = f32x4{0.f, 0.f, 0.f, 0.f};
    half8 ra[2][4], rb[2][2];
    const int ldrow = tid >> 3, ldcol = (tid & 7) * 8;
    const h16* aptr0 = (MODE == 0) ? Abase + (size_t)(m0 + ldrow) * DM + ldcol : Abase + (size_t)(m0 + ldrow) * 512 + ldcol;
    const h16* bptr0 = Wt + (size_t)(n0 + ldrow) * DM + ldcol;
#define APTR(KT) ((MODE == 0) ? aptr0 + (KT) * 64 : aptr0 + ((KT) < 8 ? (size_t)0 : (size_t)MTOT * 512) + ((KT) & 7) * 64)
#define ASTR ((size_t)64 * (MODE == 0 ? DM : 512))
#define GLOAD_PART(SET, KT, PART) do { \
      if ((PART) < 2) { const h16* ap_ = APTR(KT); ra[SET][2 * (PART)] = *(const half8*)(ap_ + (2 * (PART)) * ASTR); ra[SET][2 * (PART) + 1] = *(const half8*)(ap_ + (2 * (PART) + 1) * ASTR); } \
      else { rb[SET][0] = *(const half8*)(bptr0 + (KT) * 64); rb[SET][1] = *(const half8*)(bptr0 + (size_t)64 * DM + (KT) * 64); } } while (0)
#define SSTORE_PART(SET, BUF, PART) do { \
      if ((PART) < 2) { *(half8*)(sA + (size_t)(BUF) * 256 * 80 + (ldrow + (2 * (PART)) * 64) * 80 + ldcol) = ra[SET][2 * (PART)]; \
                        *(half8*)(sA + (size_t)(BUF) * 256 * 80 + (ldrow + (2 * (PART) + 1) * 64) * 80 + ldcol) = ra[SET][2 * (PART) + 1]; } \
      else { *(half8*)(sB + (size_t)(BUF) * 128 * 80 + ldrow * 80 + ldcol) = rb[SET][0]; *(half8*)(sB + (size_t)(BUF) * 128 * 80 + (ldrow + 64) * 80 + ldcol) = rb[SET][1]; } } while (0)
#define GLOAD(SET, KT) do { GLOAD_PART(SET, KT, 0); GLOAD_PART(SET, KT, 1); GLOAD_PART(SET, KT, 2); } while (0)
#define SSTORE(SET, BUF) do { SSTORE_PART(SET, BUF, 0); SSTORE_PART(SET, BUF, 1); SSTORE_PART(SET, BUF, 2); } while (0)
#define MMA8(KK, J0) do { \
      _Pragma("unroll") for (int j_ = (J0); j_ < (J0) + 2; ++j_) \
        _Pragma("unroll") for (int i_ = 0; i_ < 4; ++i_) acc[i_][j_] = __builtin_amdgcn_mfma_f32_16x16x32_f16(bf[KK][j_], af[KK][i_], acc[i_][j_], 0, 0, 0); } while (0)
#define STEP(BUF, SET, NBUF, KNEXT) do { \
      const h16* a_s = sA + (size_t)(BUF) * 256 * 80 + (wm * 64 + lr) * 80 + lq * 8; \
      const h16* b_s = sB + (size_t)(BUF) * 128 * 80 + (wn * 64 + lr) * 80 + lq * 8; \
      half8 af[2][4], bf[2][4]; \
      _Pragma("unroll") for (int kk = 0; kk < 2; ++kk) { \
        bf[kk][0] = *(const half8*)(b_s + kk * 32); \
        _Pragma("unroll") for (int i_ = 0; i_ < 4; ++i_) af[kk][i_] = *(const half8*)(a_s + i_ * 16 * 80 + kk * 32); \
        _Pragma("unroll") for (int j_ = 1; j_ < 4; ++j_) bf[kk][j_] = *(const half8*)(b_s + j_ * 16 * 80 + kk * 32); \
      } \
      __builtin_amdgcn_sched_barrier(0); \
      MMA8(0, 0); __builtin_amdgcn_sched_barrier(0); \
      SSTORE_PART(SET, NBUF, 0); GLOAD_PART(SET, KNEXT, 0); __builtin_amdgcn_sched_barrier(0); \
      MMA8(0, 2); __builtin_amdgcn_sched_barrier(0); \
      SSTORE_PART(SET, NBUF, 1); GLOAD_PART(SET, KNEXT, 1); __builtin_amdgcn_sched_barrier(0); \
      MMA8(1, 0); __builtin_amdgcn_sched_barrier(0); \
      SSTORE_PART(SET, NBUF, 2); GLOAD_PART(SET, KNEXT, 2); __builtin_amdgcn_sched_barrier(0); \
      MMA8(1, 2); __builtin_amdgcn_sched_barrier(0); \
      } while (0)
    constexpr int NK = DM / 64;
    GLOAD(0, 0);
    GLOAD(1, 1);
    SSTORE(0, 0);
    GLOAD(0, 2);
    lds_barrier();
#pragma unroll 1
    for (int kt = 0; kt < NK; kt += 2) {
      const int k3 = kt + 3 < NK ? kt + 3 : NK - 1, k4 = kt + 4 < NK ? kt + 4 : NK - 1;
      STEP(0, 1, 1, k3);
      lds_barrier();
      STEP(1, 0, 0, k4);
      lds_barrier();
    }
#undef GLOAD
#undef SSTORE
#undef GLOAD_PART
#undef SSTORE_PART
#undef MMA8
#undef STEP
#undef APTR
#undef ASTR
    if (MODE == 0) {
      h16* P = (h16*)(p.ws + OFF_P);
      size_t secoff; int stride, coff;
      if (n0 < 2048) { secoff = (size_t)MTOT * 512 * (n0 >> 9); stride = 512; coff = n0 & 511; }
      else if (n0 < 3712) { secoff = SEC_RW; stride = DSHIFT; coff = n0 - 2048; }
      else { secoff = SEC_GW; stride = 512; coff = n0 - 3712; }
#pragma unroll
      for (int i = 0; i < 4; ++i) {
        const int m = m0 + wm * 64 + i * 16 + lr;
#pragma unroll
        for (int j = 0; j < 4; ++j) {
          const int nl = wn * 64 + j * 16 + lq * 4;
          half4 o;
          o[0] = (h16)acc[i][j][0]; o[1] = (h16)acc[i][j][1]; o[2] = (h16)acc[i][j][2]; o[3] = (h16)acc[i][j][3];
          *(half4*)(P + secoff + (size_t)m * stride + coff + nl) = o;
        }
      }
    } else {
      const float* mod = (const float*)(p.ws + OFF_MOD) + (size_t)layer * 9 * 3072;
#pragma unroll
      for (int i = 0; i < 4; ++i) {
        const int m = m0 + wm * 64 + i * 16 + lr;
        const int cond = m < MLAT ? (m >> 11) : 8;
        const float* xo = xrow_ptr(p, layer, m);
        float* xn = m < MLAT ? p.out + (size_t)m * DM : (float*)(p.ws + OFF_XC) + (size_t)(m - MLAT) * DM;
#pragma unroll
        for (int j = 0; j < 4; ++j) {
          const int n = n0 + wn * 64 + j * 16 + lq * 4;
          const float4 g = *(const float4*)(mod + cond * 3072 + 2048 + n);
          const float4 xv = *(const float4*)(xo + n);
          float4 o;
          o.x = xv.x + g.x * acc[i][j][0]; o.y = xv.y + g.y * acc[i][j][1];
          o.z = xv.z + g.z * acc[i][j][2]; o.w = xv.w + g.w * acc[i][j][3];
          *(float4*)(xn + n) = o;
        }
      }
    }
  }
  __builtin_amdgcn_s_setprio(0);
}

__device__ __forceinline__ int chunk_row0(int b, int u) { return u < 2 ? MLAT + b * CTXL + u * 128 : b * SEQ + (u - 2) * 128; }

__device__ __forceinline__ void load_rope(const h16* src, const float2* tab, int qd, bool rope, int t, float scale, float* lo, float* hi) {
  const int hsel = qd >> 1, f0 = (qd & 1) * 8;
  const half8 a = *(const half8*)(src + hsel * 32 + f0);
  const half8 b = *(const half8*)(src + hsel * 32 + 16 + f0);
  if (rope) {
    const int pos = hsel == 0 ? (t >> 6) : (t & 63);
    const float2* tb = tab + pos * 16 + f0;
#pragma unroll
    for (int f = 0; f < 8; ++f) {
      const float2 cs = tb[f];
      const float x1 = (float)a[f], x2 = (float)b[f];
      lo[f] = (x1 * cs.x - x2 * cs.y) * scale;
      hi[f] = (x1 * cs.y + x2 * cs.x) * scale;
    }
  } else {
#pragma unroll
    for (int f = 0; f < 8; ++f) { lo[f] = (float)a[f] * scale; hi[f] = (float)b[f] * scale; }
  }
}

__device__ __forceinline__ void rope_regs(const half8 a, const half8 b, const float2* tab, int qd, bool rope, int t, float scale, float* lo, float* hi) {
  const int hsel = qd >> 1, f0 = (qd & 1) * 8;
  if (rope) {
    const int pos = hsel == 0 ? (t >> 6) : (t & 63);
    const float2* tb = tab + pos * 16 + f0;
#pragma unroll
    for (int f = 0; f < 8; ++f) {
      const float2 cs = tb[f];
      const float x1 = (float)a[f], x2 = (float)b[f];
      lo[f] = (x1 * cs.x - x2 * cs.y) * scale;
      hi[f] = (x1 * cs.y + x2 * cs.x) * scale;
    }
  } else {
#pragma unroll
    for (int f = 0; f < 8; ++f) { lo[f] = (float)a[f] * scale; hi[f] = (float)b[f] * scale; }
  }
}

__device__ __forceinline__ half4 lds_tr_read(unsigned addr) {
  half4 r;
  asm volatile("ds_read_b64_tr_b16 %0, %1" : "=&v"(r) : "v"(addr) : "memory");
  return r;
}
__device__ __forceinline__ unsigned lds_addr_of(const void* p_) {
  return (unsigned)(unsigned long)(__attribute__((address_space(3))) const void*)p_;
}

__device__ void phase_ret_kv(const Params& p_, int layer, unsigned char* smem, int wv) {
  (void)p_;
  auto kp_ = __builtin_amdgcn_kernarg_segment_ptr();
  asm volatile("" : "+s"(kp_));
  const Params p = *(const Params*)kp_;
  const int bid = BID();
  const int tid = TID(wv), lane = tid & 63, wave = tid >> 6;
  const int lr = lane & 15, lq = lane >> 4;
  const h16* P = (const h16*)(p.ws + OFF_P);
  h16* KVT = (h16*)(p.ws + OFF_H) + (size_t)MTOT * 512;
  h16* Vr = (h16*)smem;
  h16* Kf = Vr + 128 * 72;
  h16* Kb = Kf + 128 * 72;
  half8 rk0, rk1, rv0, rv1;
  auto fetch = [&](int it_) {
    const int bh_ = it_ / 18, u_ = it_ % 18;
    const size_t row_ = (size_t)(chunk_row0(bh_ >> 3, u_) + (tid >> 2));
    const int qd_ = tid & 3, hh = bh_ & 7;
    const h16* ks_ = P + SEC_K + row_ * 512 + hh * 64 + (qd_ >> 1) * 32 + (qd_ & 1) * 8;
    rk0 = *(const half8*)ks_; rk1 = *(const half8*)(ks_ + 16);
    const h16* vs_ = P + SEC_V + row_ * 512 + hh * 64 + qd_ * 16;
    rv0 = *(const half8*)vs_; rv1 = *(const half8*)(vs_ + 8);
  };
  if (bid < 64 * 18) fetch(bid);
  for (int it = bid; it < 64 * 18; it += gridDim.x) {
    const int bh = it / 18, u = it % 18, b = bh >> 3, h = bh & 7;
    const int row0 = chunk_row0(b, u);
    const float lgf = p.ret_lg[(layer * 2 + 0) * 8 + h], lgb = p.ret_lg[(layer * 2 + 1) * 8 + h];
    {
      const int j = tid >> 2, qd = tid & 3;
      const int t = (u < 2) ? 0 : (u - 2) * 128 + j;
      float lo[8], hi[8];
      rope_regs(rk0, rk1, (const float2*)(p.ws + OFF_ROPE), qd, u >= 2, t, 0.125f, lo, hi);
      const float df = expf(lgf * (float)(127 - j)), db = expf(lgb * (float)j);
      const int d0 = (qd >> 1) * 32 + (qd & 1) * 8;
      half8 fl, fh, bl, bh8;
#pragma unroll
      for (int f = 0; f < 8; ++f) { fl[f] = (h16)(lo[f] * df); fh[f] = (h16)(hi[f] * df); bl[f] = (h16)(lo[f] * db); bh8[f] = (h16)(hi[f] * db); }
      *(half8*)(Kf + j * 72 + d0) = fl; *(half8*)(Kf + j * 72 + d0 + 16) = fh;
      *(half8*)(Kb + j * 72 + d0) = bl; *(half8*)(Kb + j * 72 + d0 + 16) = bh8;
      *(half8*)(Vr + j * 72 + qd * 16) = rv0;
      *(half8*)(Vr + j * 72 + qd * 16 + 8) = rv1;
    }
    __syncthreads();
    if (it + (int)gridDim.x < 64 * 18) fetch(it + gridDim.x);
    {
      const int dir = wave >> 2, ei = wave & 3;
      const unsigned lane_off = (unsigned)(((lq * 8 + (lr >> 2)) * 72 + 4 * (lr & 3)) * 2);
      const unsigned vbase = lds_addr_of(Vr) + lane_off + (unsigned)(ei * 16 * 2);
      const unsigned kbase = lds_addr_of(dir ? Kb : Kf) + lane_off;
      half4 va[4][2], kb[4][4][2];
#pragma unroll
      for (int ks = 0; ks < 4; ++ks) {
        va[ks][0] = lds_tr_read(vbase + ks * 32 * 72 * 2);
        va[ks][1] = lds_tr_read(vbase + ks * 32 * 72 * 2 + 4 * 72 * 2);
#pragma unroll
        for (int jd = 0; jd < 4; ++jd) {
          kb[ks][jd][0] = lds_tr_read(kbase + ks * 32 * 72 * 2 + jd * 16 * 2);
          kb[ks][jd][1] = lds_tr_read(kbase + ks * 32 * 72 * 2 + jd * 16 * 2 + 4 * 72 * 2);
        }
      }
      f32x4 acc[4];
#pragma unroll
      for (int jd = 0; jd < 4; ++jd) acc[jd] = f32x4{0.f, 0.f, 0.f, 0.f};
#pragma unroll
      for (int ks = 0; ks < 4; ++ks) {
        asm volatile("s_waitcnt lgkmcnt(0)"
                     : "+v"(va[ks][0]), "+v"(va[ks][1]), "+v"(kb[ks][0][0]), "+v"(kb[ks][0][1]), "+v"(kb[ks][1][0]), "+v"(kb[ks][1][1]),
                       "+v"(kb[ks][2][0]), "+v"(kb[ks][2][1]), "+v"(kb[ks][3][0]), "+v"(kb[ks][3][1])
                     :: "memory");
        const half8 vf = {va[ks][0][0], va[ks][0][1], va[ks][0][2], va[ks][0][3], va[ks][1][0], va[ks][1][1], va[ks][1][2], va[ks][1][3]};
#pragma unroll
        for (int jd = 0; jd < 4; ++jd) {
          const half8 kf = {kb[ks][jd][0][0], kb[ks][jd][0][1], kb[ks][jd][0][2], kb[ks][jd][0][3],
                            kb[ks][jd][1][0], kb[ks][jd][1][1], kb[ks][jd][1][2], kb[ks][jd][1][3]};
          acc[jd] = __builtin_amdgcn_mfma_f32_16x16x32_f16(kf, vf, acc[jd], 0, 0, 0);
        }
      }
      h16* dst = KVT + (((size_t)dir * 64 + bh) * 18 + u) * 4096;
#pragma unroll
      for (int jd = 0; jd < 4; ++jd) {
        half4 o4;
#pragma unroll
        for (int r = 0; r < 4; ++r) o4[r] = (h16)acc[jd][r];
        *(half4*)(dst + (ei * 16 + lr) * 64 + jd * 16 + lq * 4) = o4;
      }
    }
    __syncthreads();
  }
}

__device__ void phase_ret_prefix(const Params& p_, int layer, int wv) {
  (void)p_;
  auto kp_ = __builtin_amdgcn_kernarg_segment_ptr();
  asm volatile("" : "+s"(kp_));
  const Params p = *(const Params*)kp_;
  const int bid = BID();
  const int tid = TID(wv);
  h16* KVT = (h16*)(p.ws + OFF_H) + (size_t)MTOT * 512;
  for (int idx = bid * NTHR + tid; idx < 128 * 512; idx += gridDim.x * NTHR) {
    const int seq = idx >> 9, e8 = (idx & 511) * 8;
    const int dir = seq >> 6, h = seq & 7;
    const float cd = expf(p.ret_lg[(layer * 2 + dir) * 8 + h] * 128.f);
    h16* base = KVT + (size_t)seq * 18 * 4096 + e8;
    half8 kv[18];
#pragma unroll
    for (int pp = 0; pp < 18; ++pp) {
      const int uu = dir == 0 ? pp : (pp < 2 ? 1 - pp : 19 - pp);
      kv[pp] = *(const half8*)(base + (size_t)uu * 4096);
    }
    float a[8];
#pragma unroll
    for (int i = 0; i < 8; ++i) a[i] = 0.f;
#pragma unroll
    for (int pp = 0; pp < 18; ++pp) {
      const int uu = dir == 0 ? pp : (pp < 2 ? 1 - pp : 19 - pp);
      half8 o;
#pragma unroll
      for (int i = 0; i < 8; ++i) o[i] = (h16)a[i];
      *(half8*)(base + (size_t)uu * 4096) = o;
#pragma unroll
      for (int i = 0; i < 8; ++i) a[i] = a[i] * cd + (float)kv[pp][i];
    }
  }
}

__device__ void phase_ret_out(const Params& p_, int layer, unsigned char* smem, int wv) {
  (void)p_;
  auto kp_ = __builtin_amdgcn_kernarg_segment_ptr();
  asm volatile("" : "+s"(kp_));
  const Params p = *(const Params*)kp_;
  const int bid = BID();
  const int tid = TID(wv), lane = tid & 63, wave = tid >> 6;
  const int lr = lane & 15, lq = lane >> 4;
  const h16* P = (const h16*)(p.ws + OFF_P);
  const h16* KVT = (const h16*)(p.ws + OFF_H) + (size_t)MTOT * 512;
  h16* MIXret = (h16*)(p.ws + OFF_H);
  h16* Qs = (h16*)smem;
  h16* Ks = Qs + 128 * 80;
  h16* VT = Ks + 128 * 80;
  h16* SC = VT + 64 * 144;
  h16* SfT = SC + 128 * 144;
  h16* SbT = SfT + 64 * 80;
  const int u_lo = layer == 0 ? 0 : 2, nu = 18 - u_lo;
  for (int it = bid; it < 64 * nu; it += gridDim.x) {
    const int bh = it / nu, u = u_lo + it % nu, b = bh >> 3, h = bh & 7;
    const int row0 = chunk_row0(b, u);
    const float lgf = p.ret_lg[(layer * 2 + 0) * 8 + h], lgb = p.ret_lg[(layer * 2 + 1) * 8 + h];
    {
      const int j = tid >> 2, qd = tid & 3;
      const size_t row = (size_t)(row0 + j);
      const int t = (u < 2) ? 0 : (u - 2) * 128 + j;
      const int d0 = (qd >> 1) * 32 + (qd & 1) * 8;
      float lo[8], hi[8];
      load_rope(P + SEC_Q + row * 512 + h * 64, (const float2*)(p.ws + OFF_ROPE), qd, u >= 2, t, 1.f, lo, hi);
      half8 o0, o1;
#pragma unroll
      for (int f = 0; f < 8; ++f) { o0[f] = (h16)lo[f]; o1[f] = (h16)hi[f]; }
      *(half8*)(Qs + j * 80 + d0) = o0; *(half8*)(Qs + j * 80 + d0 + 16) = o1;
      load_rope(P + SEC_K + row * 512 + h * 64, (const float2*)(p.ws + OFF_ROPE), qd, u >= 2, t, 0.125f, lo, hi);
#pragma unroll
      for (int f = 0; f < 8; ++f) { o0[f] = (h16)lo[f]; o1[f] = (h16)hi[f]; }
      *(half8*)(Ks + j * 80 + d0) = o0; *(half8*)(Ks + j * 80 + d0 + 16) = o1;
      const h16* vs = P + SEC_V + row * 512 + h * 64 + qd * 16;
      const half8 v0 = *(const half8*)vs, v1 = *(const half8*)(vs + 8);
#pragma unroll
      for (int f = 0; f < 8; ++f) { VT[(qd * 16 + f) * 144 + j] = v0[f]; VT[(qd * 16 + 8 + f) * 144 + j] = v1[f]; }
    }
    {
      const int e = tid >> 3, d8 = (tid & 7) * 8;
      const half8 of = *(const half8*)(KVT + (((size_t)0 * 64 + bh) * 18 + u) * 4096 + e * 64 + d8);
      const half8 ob = *(const half8*)(KVT + (((size_t)1 * 64 + bh) * 18 + u) * 4096 + e * 64 + d8);
      *(half8*)(SfT + e * 80 + d8) = of;
      *(half8*)(SbT + e * 80 + d8) = ob;
    }
    __syncthreads();
    {
      const int i_loc = wave * 16 + lr;
      half8 qf[2];
      qf[0] = *(const half8*)(Qs + i_loc * 80 + lq * 8);
      qf[1] = *(const half8*)(Qs + i_loc * 80 + 32 + lq * 8);
      const float l2f = lgf * 1.44269504f, l2b = lgb * 1.44269504f;
#pragma unroll
      for (int js = 0; js < 8; ++js) {
        f32x4 s = f32x4{0.f, 0.f, 0.f, 0.f};
#pragma unroll
        for (int kk = 0; kk < 2; ++kk) {
          const half8 kf = *(const half8*)(Ks + (js * 16 + lr) * 80 + kk * 32 + lq * 8);
          s = __builtin_amdgcn_mfma_f32_16x16x32_f16(kf, qf[kk], s, 0, 0, 0);
        }
        half4 o;
#pragma unroll
        for (int r = 0; r < 4; ++r) {
          const int j = js * 16 + lq * 4 + r;
          const int rel = i_loc - j;
          const float m = rel > 0 ? exp2f(l2f * (float)rel) : (rel < 0 ? exp2f(l2b * (float)(-rel)) : 2.f);
          o[r] = (h16)(s[r] * m);
        }
        *(half4*)(SC + i_loc * 144 + js * 16 + lq * 4) = o;
      }
    }
    __syncthreads();
    {
      const int i_loc = wave * 16 + lr;
      f32x4 ai[4], xf[4], xb[4];
#pragma unroll
      for (int je = 0; je < 4; ++je) { ai[je] = f32x4{0.f, 0.f, 0.f, 0.f}; xf[je] = ai[je]; xb[je] = ai[je]; }
#pragma unroll
      for (int ks = 0; ks < 4; ++ks) {
        const half8 sf = *(const half8*)(SC + i_loc * 144 + ks * 32 + lq * 8);
#pragma unroll
        for (int je = 0; je < 4; ++je) {
          const half8 vf = *(const half8*)(VT + (je * 16 + lr) * 144 + ks * 32 + lq * 8);
          ai[je] = __builtin_amdgcn_mfma_f32_16x16x32_f16(vf, sf, ai[je], 0, 0, 0);
        }
      }
#pragma unroll
      for (int kk = 0; kk < 2; ++kk) {
        const half8 qf = *(const half8*)(Qs + i_loc * 80 + kk * 32 + lq * 8);
#pragma unroll
        for (int je = 0; je < 4; ++je) {
          const half8 s1 = *(const half8*)(SfT + (je * 16 + lr) * 80 + kk * 32 + lq * 8);
          const half8 s2 = *(const half8*)(SbT + (je * 16 + lr) * 80 + kk * 32 + lq * 8);
          xf[je] = __builtin_amdgcn_mfma_f32_16x16x32_f16(s1, qf, xf[je], 0, 0, 0);
          xb[je] = __builtin_amdgcn_mfma_f32_16x16x32_f16(s2, qf, xb[je], 0, 0, 0);
        }
      }
      const float df = expf(lgf * (float)(i_loc + 1)), db = expf(lgb * (float)(128 - i_loc));
      float o[4][4], ss = 0.f;
#pragma unroll
      for (int je = 0; je < 4; ++je)
#pragma unroll
        for (int r = 0; r < 4; ++r) { o[je][r] = ai[je][r] + df * xf[je][r] + db * xb[je][r]; ss += o[je][r] * o[je][r]; }
      ss += shx(ss, lane, 16);
      ss += shx(ss, lane, 32);
      const float rn = rsqrtf(ss * (1.f / 64.f) + NORM_EPS);
      const size_t row = (size_t)(row0 + i_loc);
#pragma unroll
      for (int je = 0; je < 4; ++je) {
        const int e = je * 16 + lq * 4;
        const half4 g = *(const half4*)(P + SEC_GR + row * 512 + h * 64 + e);
        const float4 nw = *(const float4*)(p.ret_nw + layer * 512 + h * 64 + e);
        half4 res;
        res[0] = (h16)(o[je][0] * rn * nw.x * silu_f((float)g[0]));
        res[1] = (h16)(o[je][1] * rn * nw.y * silu_f((float)g[1]));
        res[2] = (h16)(o[je][2] * rn * nw.z * silu_f((float)g[2]));
        res[3] = (h16)(o[je][3] * rn * nw.w * silu_f((float)g[3]));
        *(half4*)(MIXret + row * 512 + h * 64 + e) = res;
      }
    }
    __syncthreads();
  }
}

typedef float f32x2 __attribute__((ext_vector_type(2)));
__device__ __forceinline__ f32x2 pk_fma(f32x2 a, f32x2 b, f32x2 c) { return __builtin_elementwise_fma(a, b, c); }

constexpr int SC_BUF_FLOATS = 32 * 64 * 2 + 32 * 4 * 64;

struct ScanOps { f32x4 kp0, kp1, b0, b1, m0, m1, r0, r1; float v; };
__device__ __forceinline__ void scan_load(ScanOps& o, const float* bufp, int st, int kq, int vrow) {
  const float* fd = bufp + 4096 + st * 256 + kq * 8;
  o.kp0 = *(const f32x4*)(fd + 192); o.kp1 = *(const f32x4*)(fd + 196);
  o.b0 = *(const f32x4*)(fd + 64); o.b1 = *(const f32x4*)(fd + 68);
  o.m0 = *(const f32x4*)(fd + 128); o.m1 = *(const f32x4*)(fd + 132);
  const float* rp = bufp + st * 64 + kq * 8;
  o.r0 = *(const f32x4*)rp; o.r1 = *(const f32x4*)(rp + 4);
  o.v = bufp[2048 + st * 64 + vrow];
}

__device__ void phase_rwkv_scan(const Params& p_, int layer, unsigned char* smem, int wv) {
  (void)p_;
  auto kp_ = __builtin_amdgcn_kernarg_segment_ptr();
  asm volatile("" : "+s"(kp_));
  const Params p = *(const Params*)kp_;
  const int bid = BID();
  const int tid = TID(wv), lane = tid & 63, wave = tid >> 6;
  const int lr = lane & 15, lq = lane >> 4;
  const h16* Prw = (const h16*)(p.ws + OFF_P) + SEC_RW;
  h16* Y = (h16*)(p.ws + OFF_Y);
  float* bufs = (float*)smem;
  float* ck = bufs + 2 * SC_BUF_FLOATS;
  float* sws = ck + 32 * 64;
  h16* xw16 = (h16*)(sws + 3 * 5 * 64 + 8);
  h16* xa16 = xw16 + 32 * 80;
  h16* w2h = xa16 + 32 * 80;
  h16* a2h = w2h + 64 * 80;
  float* scon = (float*)(a2h + 64 * 80);
  for (int it0 = bid; it0 < 256; it0 += gridDim.x) {
    int it = it0;
    if (gridDim.x == 256) { const int xcd = it0 & 7, slot = it0 >> 3; it = ((xcd * 8 + (slot >> 2)) << 2) | (slot & 3); }
    const int chain = it >> 1, rh = it & 1;
    const int b = chain >> 4, h = (chain >> 1) & 7, d = chain & 1;
    __syncthreads();
    for (int i = tid; i < 960; i += NTHR) {
      const int tap = i / 320, g = (i % 320) >> 6, c = i & 63;
      const int col = g < 3 ? g * 512 + h * 64 + c : 1536 + (g - 3) * 64 + c;
      ((h16*)sws)[i] = (h16)p.shift_w[((size_t)layer * 3 + tap) * DSHIFT + col];
    }
    if (tid < 8) ((h16*)sws)[960 + tid] = (h16)0.f;
    for (int i = tid; i < 4096; i += NTHR) {
      const int k = i >> 6, n = i & 63;
      w2h[n * 80 + k] = (h16)p.w2[(((size_t)layer * 2 + d) * 64 + k) * 512 + h * 64 + n];
      a2h[n * 80 + k] = (h16)p.a2[(((size_t)layer * 2 + d) * 64 + k) * 512 + h * 64 + n];
    }
    if (tid < 192) {
      const int w_ = tid >> 6, c = tid & 63;
      scon[tid] = w_ == 0 ? p.w0[(layer * 2 + d) * 512 + h * 64 + c] : (w_ == 1 ? p.a0[(layer * 2 + d) * 512 + h * 64 + c] : p.k_a[layer * 512 + h * 64 + c]);
    }
    __syncthreads();
    if (wave >= 4) {
      const int bw = wave - 4;
      const int st = bw * 8 + (lane >> 3), c8 = (lane & 7) * 8;
      const bool isA = (lr & 1) != 0;
      const int tokL = bw * 8 + (lr >> 1);
      const float4 kk0 = *(const float4*)(p.k_k + layer * 512 + h * 64 + c8);
      const float4 kk1 = *(const float4*)(p.k_k + layer * 512 + h * 64 + c8 + 4);
      half8 pf[5][3];
      auto prefetch = [&](int ci) {
        const bool isctx = ci < 8;
        const int lc = isctx ? ci : ci - 8;
        const int L = isctx ? CTXL : SEQ;
        const int rowbase = isctx ? MLAT + b * CTXL : b * SEQ;
        const int pos = lc * 32 + st;
        const int t = d ? L - 1 - pos : pos;
        const h16* rowp = Prw + (size_t)(rowbase + t) * DSHIFT + c8;
#pragma unroll
        for (int g = 0; g < 5; ++g) {
          const int col = (g < 3 ? g * 512 + h * 64 : 1536 + (g - 3) * 64);
          const h16* src = rowp + col;
          pf[g][1] = *(const half8*)src;
          pf[g][0] = *(const half8*)(src - (t > 0 ? DSHIFT : 0));
          pf[g][2] = *(const half8*)(src + (t < L - 1 ? DSHIFT : 0));
        }
      };
      auto build_conv = [&](float* bufp, int ci) {
        const bool isctx = ci < 8;
        const int pos_ = (isctx ? ci : ci - 8) * 32 + st;
        const int L_ = isctx ? CTXL : SEQ;
        const int t_ = d ? L_ - 1 - pos_ : pos_;
        const h16* swh = (const h16*)sws;
        const h16* swa = (t_ > 0) ? swh + c8 : swh + 960;
        const h16* swc = (t_ < L_ - 1) ? swh + 2 * 5 * 64 + c8 : swh + 960;
        const int gstr_a = (t_ > 0) ? 64 : 0, gstr_c = (t_ < L_ - 1) ? 64 : 0;
#pragma unroll
        for (int g = 0; g < 5; ++g) {
          const half8 wa = *(const half8*)(swa + g * gstr_a);
          const half8 wb = *(const half8*)(swh + (1 * 5 + g) * 64 + c8);
          const half8 wc = *(const half8*)(swc + g * gstr_c);
          const half8 oh = wa * pf[g][0] + wb * pf[g][1] + wc * pf[g][2];
          float o[8];
          if (g < 4) {
#pragma unroll
            for (int i = 0; i < 8; ++i) o[i] = (float)oh[i];
          }
          if (g < 3) {
            float* dst = (g == 0 ? bufp : (g == 1 ? ck : bufp + 2048)) + st * 64 + c8;
            *(float4*)dst = float4{o[0], o[1], o[2], o[3]};
            *(float4*)(dst + 4) = float4{o[4], o[5], o[6], o[7]};
            if (g == 1) {
              float kk[8] = {o[0] * kk0.x, o[1] * kk0.y, o[2] * kk0.z, o[3] * kk0.w, o[4] * kk1.x, o[5] * kk1.y, o[6] * kk1.z, o[7] * kk1.w};
              float ss = 0.f;
#pragma unroll
              for (int i = 0; i < 8; ++i) ss += kk[i] * kk[i];
              ss = reduce8(ss);
              const float inv = __builtin_amdgcn_rsqf(fmaxf(ss, 1e-24f));
              float* kd = bufp + 4096 + st * 256 + 192 + c8;
              *(float4*)kd = float4{kk[0] * inv, kk[1] * inv, kk[2] * inv, kk[3] * inv};
              *(float4*)(kd + 4) = float4{kk[4] * inv, kk[5] * inv, kk[6] * inv, kk[7] * inv};
            }
          } else {
            half8 ho;
            if (g == 3) {
#pragma unroll
              for (int i = 0; i < 8; ++i) ho[i] = (h16)(1.f - 2.f * __builtin_amdgcn_rcpf(1.f + __expf(2.f * o[i])));
            } else {
              ho = oh;
            }
            *(half8*)((g == 3 ? xw16 : xa16) + st * 80 + c8) = ho;
          }
        }
      };
      auto build_lora = [&](float* bufp) {
        half8 xwf[2], xaf[2];
#pragma unroll
        for (int kk = 0; kk < 2; ++kk) {
          xwf[kk] = *(const half8*)(xw16 + tokL * 80 + kk * 32 + lq * 8);
          xaf[kk] = *(const half8*)(xa16 + tokL * 80 + kk * 32 + lq * 8);
        }
        f32x4 aw[4], aa[4];
#pragma unroll
        for (int ns = 0; ns < 4; ++ns) {
          aw[ns] = f32x4{0.f, 0.f, 0.f, 0.f}; aa[ns] = aw[ns];
#pragma unroll
          for (int kk = 0; kk < 2; ++kk) {
            const half8 wf = *(const half8*)(w2h + (ns * 16 + lr) * 80 + kk * 32 + lq * 8);
            const half8 af = *(const half8*)(a2h + (ns * 16 + lr) * 80 + kk * 32 + lq * 8);
            aw[ns] = __builtin_amdgcn_mfma_f32_16x16x32_f16(wf, xwf[kk], aw[ns], 0, 0, 0);
            aa[ns] = __builtin_amdgcn_mfma_f32_16x16x32_f16(af, xaf[kk], aa[ns], 0, 0, 0);
          }
        }
        const bool hf = isA;
        const int tk = lr >> 1;
#pragma unroll
        for (int jj = 0; jj < 2; ++jj) {
          const int c = (hf ? 32 : 0) + jj * 16 + lq * 4;
          const f32x4 c0w = *(const f32x4*)(scon + c), c0a = *(const f32x4*)(scon + 64 + c), ka = *(const f32x4*)(scon + 128 + c);
          float sgw[4], sga[4], Lv[4];
#pragma unroll
          for (int r = 0; r < 4; ++r) {
            const float xw_ = c0w[r] + (hf ? aw[2 + jj][r] : aw[jj][r]);
            const float xa_ = c0a[r] + (hf ? aa[2 + jj][r] : aa[jj][r]);
            sgw[r] = __builtin_amdgcn_rcpf(1.f + __expf(-xw_));
            sga[r] = __builtin_amdgcn_rcpf(1.f + __expf(-xa_));
            float x = -0.60653066f * sgw[r];
            x += dppf<0x112>(x);
            x += dppf<0x114>(x);
            x += dppf<0x118>(x);
            Lv[r] = x;
          }
          float* fd = bufp + 4096 + tokL * 256 + c;
          float e[4], en[4], ep[4];
#pragma unroll
          for (int r = 0; r < 4; ++r) {
            e[r] = __expf(Lv[r]); en[r] = __builtin_amdgcn_rcpf(e[r]);
            const float pe = dppf<0x112>(e[r]);
            ep[r] = (tk == 0) ? 1.f : pe;
          }
          float* rp = bufp + tokL * 64 + c;
          const float4 rv = *(const float4*)rp;
          *(float4*)rp = float4{rv.x * e[0], rv.y * e[1], rv.z * e[2], rv.w * e[3]};
          const float4 kv = *(const float4*)(ck + tokL * 64 + c);
          const float4 kp = *(const float4*)(fd + 192);
          if (tk == 7) *(float4*)fd = float4{e[0], e[1], e[2], e[3]};
          *(float4*)(fd + 64) = float4{kp.x * sga[0] * en[0], kp.y * sga[1] * en[1], kp.z * sga[2] * en[2], kp.w * sga[3] * en[3]};
          *(float4*)(fd + 128) = float4{kv.x * (1.f + (sga[0] - 1.f) * ka[0]) * en[0], kv.y * (1.f + (sga[1] - 1.f) * ka[1]) * en[1],
                                        kv.z * (1.f + (sga[2] - 1.f) * ka[2]) * en[2], kv.w * (1.f + (sga[3] - 1.f) * ka[3]) * en[3]};
          *(float4*)(fd + 192) = float4{kp.x * ep[0], kp.y * ep[1], kp.z * ep[2], kp.w * ep[3]};
        }
      };
      prefetch(0);
      build_conv(bufs, 0);
      prefetch(1);
      build_lora(bufs);
      lds_barrier();
      for (int ci = 0; ci < 72; ++ci) {
        if (ci + 1 < 72) {
          float* bufp = bufs + ((ci + 1) & 1) * SC_BUF_FLOATS;
          build_conv(bufp, ci + 1);
          if (ci + 2 < 72) prefetch(ci + 2);
          build_lora(bufp);
        }
        lds_barrier();
      }
    } else {
      __builtin_amdgcn_s_setprio(0);
      const int kq = lane & 7, rsub = lane >> 3;
      const int vrow = rh * 32 + wave * 8 + rsub;
      f32x2 s0 = {0.f, 0.f}, s1 = s0, s2 = s0, s3 = s0;
      float ysel = 0.f;
      float yp[8];
      lds_barrier();
      for (int ci = 0; ci < 72; ++ci) {
        const bool isctx = ci < 8;
        const int lc = isctx ? ci : ci - 8;
        const int L = isctx ? CTXL : SEQ;
        const int rowbase = isctx ? MLAT + b * CTXL : b * SEQ;
        const float* bufp = bufs + (ci & 1) * SC_BUF_FLOATS;
        ScanOps cur, nxt;
        scan_load(cur, bufp, 0, kq, vrow);
#pragma unroll 1
        for (int s8 = 0; s8 < 32; s8 += 8) {
#pragma unroll
          for (int u = 0; u < 8; ++u) {
            const int st = s8 + u;
            scan_load(nxt, bufp, (st + 1) & 31, kq, vrow);
            f32x2 t2 = s0 * f32x2{cur.kp0[0], cur.kp0[1]};
            t2 = pk_fma(s1, f32x2{cur.kp0[2], cur.kp0[3]}, t2);
            t2 = pk_fma(s2, f32x2{cur.kp1[0], cur.kp1[1]}, t2);
            t2 = pk_fma(s3, f32x2{cur.kp1[2], cur.kp1[3]}, t2);
            const float sk = reduce8(t2[0] + t2[1]);
            const f32x2 nsk = {-sk, -sk}, vv = {cur.v, cur.v};
            s0 = pk_fma(vv, f32x2{cur.m0[0], cur.m0[1]}, pk_fma(nsk, f32x2{cur.b0[0], cur.b0[1]}, s0));
            s1 = pk_fma(vv, f32x2{cur.m0[2], cur.m0[3]}, pk_fma(nsk, f32x2{cur.b0[2], cur.b0[3]}, s1));
            s2 = pk_fma(vv, f32x2{cur.m1[0], cur.m1[1]}, pk_fma(nsk, f32x2{cur.b1[0], cur.b1[1]}, s2));
            s3 = pk_fma(vv, f32x2{cur.m1[2], cur.m1[3]}, pk_fma(nsk, f32x2{cur.b1[2], cur.b1[3]}, s3));
            f32x2 y2 = s0 * f32x2{cur.r0[0], cur.r0[1]};
            y2 = pk_fma(s1, f32x2{cur.r0[2], cur.r0[3]}, y2);
            y2 = pk_fma(s2, f32x2{cur.r1[0], cur.r1[1]}, y2);
            y2 = pk_fma(s3, f32x2{cur.r1[2], cur.r1[3]}, y2);
            yp[u] = y2[0] + y2[1];
            cur = nxt;
          }
          {
            const bool hiq = (kq & 4) != 0;
            float q4[4];
#pragma unroll
            for (int j = 0; j < 4; ++j) {
              const float keep = hiq ? yp[4 + j] : yp[j], send = hiq ? yp[j] : yp[4 + j];
              q4[j] = keep + dppf<0x141>(send);
            }
            const bool b0 = (kq & 1) != 0;
            float q2[2];
#pragma unroll
            for (int j = 0; j < 2; ++j) {
              const float keep = b0 ? q4[2 * j + 1] : q4[2 * j], send = b0 ? q4[2 * j] : q4[2 * j + 1];
              q2[j] = keep + dppf<0xB1>(send);
            }
            const bool b1 = (kq & 2) != 0;
            const float keep = b1 ? q2[1] : q2[0], send = b1 ? q2[0] : q2[1];
            ysel = keep + dppf<0x4E>(send);
          }
          {
            const float* gp = bufp + 4096 + (s8 + 7) * 256 + kq * 8;
            const f32x4 g0 = *(const f32x4*)gp, g1 = *(const f32x4*)(gp + 4);
            s0 = s0 * f32x2{g0[0], g0[1]}; s1 = s1 * f32x2{g0[2], g0[3]};
            s2 = s2 * f32x2{g1[0], g1[1]}; s3 = s3 * f32x2{g1[2], g1[3]};
            const int pos = lc * 32 + s8 + kq;
            const int t = d ? L - 1 - pos : pos;
            Y[((size_t)d * MTOT + rowbase + t) * 512 + h * 64 + vrow] = (h16)ysel;
          }
        }
        lds_barrier();
      }
      __builtin_amdgcn_s_setprio(0);
    }
  }
}

__device__ void phase_rwkv_readout(const Params& p_, int layer, int wv) {
  (void)p_;
  auto kp_ = __builtin_amdgcn_kernarg_segment_ptr();
  asm volatile("" : "+s"(kp_));
  const Params p = *(const Params*)kp_;
  const int bid = BID();
  const int tid_ = TID(wv); const int lane = tid_ & 63, wave = tid_ >> 6;
  const h16* P = (const h16*)(p.ws + OFF_P);
  const h16* Prw = P + SEC_RW;
  const h16* Y = (const h16*)(p.ws + OFF_Y);
  h16* MIXrw = (h16*)(p.ws + OFF_H) + (size_t)MTOT * 512;
  const int Mrows = layer == 0 ? MTOT : MLAT;
  const int head = lane >> 3, c0 = (lane & 7) * 8, ch = head * 64 + c0;
  float swr[3][3][8], rk[8], lw[8], lb[8];
  {
    const float* sw = p.shift_w + (size_t)layer * 3 * DSHIFT;
#pragma unroll
    for (int tap = 0; tap < 3; ++tap)
#pragma unroll
      for (int g = 0; g < 3; ++g)
#pragma unroll
        for (int i = 0; i < 8; ++i) swr[tap][g][i] = sw[tap * DSHIFT + g * 512 + ch + i];
#pragma unroll
    for (int i = 0; i < 8; ++i) { rk[i] = p.r_k[layer * 512 + ch + i]; lw[i] = p.ln_w[layer * 512 + ch + i]; lb[i] = p.ln_b[layer * 512 + ch + i]; }
  }
  for (int m = bid * 8 + wave; m < Mrows; m += gridDim.x * 8) {
    const int t = m < MLAT ? (m & (SEQ - 1)) : ((m - MLAT) & (CTXL - 1));
    const int L = m < MLAT ? SEQ : CTXL;
    const half8 yf = *(const half8*)(Y + (size_t)m * 512 + ch);
    const half8 yb = *(const half8*)(Y + ((size_t)MTOT + m) * 512 + ch);
    const half8 gw = *(const half8*)(P + SEC_GW + (size_t)m * 512 + ch);
    half8 pr[3][3];
#pragma unroll
    for (int g = 0; g < 3; ++g) {
      const h16* src = Prw + (size_t)m * DSHIFT + g * 512 + ch;
      pr[g][1] = *(const half8*)src;
      pr[g][0] = *(const half8*)(src - (t > 0 ? DSHIFT : 0));
      pr[g][2] = *(const half8*)(src + (t < L - 1 ? DSHIFT : 0));
    }
    const float m0 = t > 0 ? 1.f : 0.f, m2 = t < L - 1 ? 1.f : 0.f;
    float y[8], sum = 0.f;
#pragma unroll
    for (int i = 0; i < 8; ++i) { y[i] = (float)yf[i] + (float)yb[i]; sum += y[i]; }
    const float mu = reduce8(sum) * (1.f / 64.f);
    float vs = 0.f;
#pragma unroll
    for (int i = 0; i < 8; ++i) { y[i] -= mu; vs += y[i] * y[i]; }
    const float rstd = rsqrtf(reduce8(vs) * (1.f / 64.f) + GN_EPS);
    float cv[3][8];
#pragma unroll
    for (int g = 0; g < 3; ++g)
#pragma unroll
      for (int i = 0; i < 8; ++i)
        cv[g][i] = swr[0][g][i] * m0 * (float)pr[g][0][i] + swr[1][g][i] * (float)pr[g][1][i] + swr[2][g][i] * m2 * (float)pr[g][2][i];
    float dot = 0.f;
#pragma unroll
    for (int i = 0; i < 8; ++i) dot += cv[0][i] * cv[1][i] * rk[i];
    dot = reduce8(dot);
    half8 o;
#pragma unroll
    for (int i = 0; i < 8; ++i) {
      const float val = y[i] * rstd * lw[i] + lb[i] + dot * cv[2][i];
      o[i] = (h16)(val * silu_f((float)gw[i]));
    }
    *(half8*)(MIXrw + (size_t)m * 512 + ch) = o;
  }
}

__device__ void phase_final(const Params& p_, int wv) {
  (void)p_;
  auto kp_ = __builtin_amdgcn_kernarg_segment_ptr();
  asm volatile("" : "+s"(kp_));
  const Params p = *(const Params*)kp_;
  const int bid = BID();
  const int tid_ = TID(wv); const int lane = tid_ & 63, wave = tid_ >> 6;
  const int nwv = gridDim.x * 8;
  for (int row = bid * 8 + wave; row < MLAT; row += 2 * nwv) {
    const int row2 = row + nwv;
    const bool has2 = row2 < MLAT;
    float* xr = p.out + (size_t)row * DM;
    float* xr2 = p.out + (size_t)(has2 ? row2 : row) * DM;
    float4 v[4], w[4];
    float ss = 0.f, ss2 = 0.f;
#pragma unroll
    for (int j = 0; j < 4; ++j) { v[j] = *(const float4*)(xr + j * 256 + lane * 4); w[j] = *(const float4*)(xr2 + j * 256 + lane * 4); }
#pragma unroll
    for (int j = 0; j < 4; ++j) {
      ss += v[j].x * v[j].x + v[j].y * v[j].y + v[j].z * v[j].z + v[j].w * v[j].w;
      ss2 += w[j].x * w[j].x + w[j].y * w[j].y + w[j].z * w[j].z + w[j].w * w[j].w;
    }
    ss = wave_sum(ss, lane);
    ss2 = wave_sum(ss2, lane);
    const float rstd = rsqrtf(ss * (1.f / DM) + NORM_EPS), rstd2 = rsqrtf(ss2 * (1.f / DM) + NORM_EPS);
#pragma unroll
    for (int j = 0; j < 4; ++j) {
      const int col = j * 256 + lane * 4;
      const float4 w4 = *(const float4*)(p.fnw + col);
      float4 o;
      o.x = v[j].x * rstd * w4.x; o.y = v[j].y * rstd * w4.y; o.z = v[j].z * rstd * w4.z; o.w = v[j].w * rstd * w4.w;
      *(float4*)(xr + col) = o;
      if (has2) {
        float4 o2;
        o2.x = w[j].x * rstd2 * w4.x; o2.y = w[j].y * rstd2 * w4.y; o2.z = w[j].z * rstd2 * w4.z; o2.w = w[j].w * rstd2 * w4.w;
        *(float4*)(xr2 + col) = o2;
      }
    }
  }
}

#define XB_TMO      128
#define XB_XCNT(j)  (256  + 64 * (j))
#define XB_XSUB(j)  (1280 + 64 * (j))
#define XB_XGEN(j)  (2304 + 64 * (j))
#define XB_TOP      3328
#define XB_TOPGEN   3392
#define XCD_BAR_WORDS 3456
#define XB_SPIN_CAP (1u << 18)
#define LAS __attribute__((address_space(3)))
__device__ __forceinline__ unsigned xb_ld(unsigned* p)              { return __hip_atomic_load(p, __ATOMIC_RELAXED, __HIP_MEMORY_SCOPE_AGENT); }
__device__ __forceinline__ unsigned xb_add(unsigned* p, unsigned v) { return __hip_atomic_fetch_add(p, v, __ATOMIC_RELAXED, __HIP_MEMORY_SCOPE_AGENT); }
__device__ __forceinline__ unsigned xb_xcc_id() { return (unsigned)__builtin_amdgcn_s_getreg((3 << 11) | 20) & 0xFu; }
#define XB_SPIN(cond, bar) do { unsigned _sp = 0; while (cond) { __builtin_amdgcn_s_sleep(1); \
    if ((++_sp & 255u) == 0u) { if (xb_ld(&(bar)[XB_TMO])) break; if (_sp > XB_SPIN_CAP) { atomicAdd(&(bar)[XB_TMO], 1u); break; } } } } while (0)
struct XcdBarrier { unsigned* bar; unsigned x; volatile LAS unsigned* st; int wv; };
__device__ __forceinline__ XcdBarrier xcd_barrier_post(unsigned* bar, volatile LAS unsigned* st, int wv) {
    XcdBarrier b; b.bar = bar; b.x = xb_xcc_id(); b.st = st; b.wv = wv;
    if (TID(wv) == 0) (void)xb_add(&bar[XB_XCNT(b.x)], 1u);
    return b;
}
__device__ __forceinline__ void xcd_barrier_complete(unsigned* bar, unsigned x, unsigned& nloc, unsigned& nx) {
    const unsigned G = gridDim.x * gridDim.y * gridDim.z;
    unsigned sum, cnt, mine, sp = 0u;
    for (;;) {
        sum = 0u; cnt = 0u; mine = 0u;
#pragma unroll
        for (unsigned j = 0; j < 16; ++j) { const unsigned c = xb_ld(&bar[XB_XCNT(j)]); sum += c; cnt += (c > 0u) ? 1u : 0u; mine = (j == x) ? c : mine; }
        if (sum == G) break;
        __builtin_amdgcn_s_sleep(1);
        if ((++sp & 255u) == 0u) { if (xb_ld(&bar[XB_TMO])) break; if (sp > XB_SPIN_CAP) { atomicAdd(&bar[XB_TMO], 1u); break; } }
    }
    nloc = mine > 0u ? mine : 1u; nx = cnt > 0u ? cnt : 1u;
}
__device__ __forceinline__ void xcd_barrier(const XcdBarrier& b) {
    const int wv = b.wv;
    asm volatile("s_waitcnt vmcnt(0)" ::: "memory");
    __syncthreads();
    if (TID(wv) == 0) {
        unsigned* bar = b.bar;
        __builtin_amdgcn_s_waitcnt(0);
        unsigned nloc = b.st[0], nx = b.st[1];
        if (nloc == 0u) { xcd_barrier_complete(bar, b.x, nloc, nx); b.st[0] = nloc; b.st[1] = nx; }
        const unsigned old = xb_add(&bar[XB_XSUB(b.x)], 1u);
        const unsigned gen = old / nloc;
        if (old + 1u == (gen + 1u) * nloc) {
            __builtin_amdgcn_fence(__ATOMIC_RELEASE, "agent");
            asm volatile("s_waitcnt vmcnt(0)" ::: "memory");
            const unsigned og = xb_add(&bar[XB_TOP], 1u);
            const unsigned tg = og / nx;
            if (og + 1u == (tg + 1u) * nx) xb_add(&bar[XB_TOPGEN], 1u);
            else XB_SPIN(xb_ld(&bar[XB_TOPGEN]) == tg, bar);
            __builtin_amdgcn_fence(__ATOMIC_ACQUIRE, "agent");
            xb_add(&bar[XB_XGEN(b.x)], 1u);
            asm volatile("s_waitcnt vmcnt(0)" ::: "memory");
        } else {
            XB_SPIN(xb_ld(&bar[XB_XGEN(b.x)]) == gen, bar);
            __builtin_amdgcn_fence(__ATOMIC_ACQUIRE, "agent");
            asm volatile("s_waitcnt vmcnt(0)" ::: "memory");
        }
    }
    __syncthreads();
}

__global__ void __launch_bounds__(NTHR) fwd_megakernel(Params p) {
  __shared__ __attribute__((aligned(16))) unsigned char smem[SMEM_BYTES];
  cg::grid_group grid = cg::this_grid();
  const int wv = __builtin_amdgcn_readfirstlane((int)threadIdx.x >> 6);
  __shared__ uint4 xb_words;
  if (TID(wv) == 0) xb_words = make_uint4(0u, 0u, 0u, 0u);
  __syncthreads();
  (void)xcd_barrier_post((unsigned*)(p.ws + OFF_BAR), (volatile LAS unsigned*)&xb_words, wv);
#define XBAR() do { XcdBarrier xb_; xb_.bar = (unsigned*)(p.ws + OFF_BAR); xb_.x = xb_xcc_id(); xb_.st = (volatile LAS unsigned*)&xb_words; xb_.wv = wv; xcd_barrier(xb_); } while (0)
#ifndef SK_A
  phase_adaln(p, smem, wv);
#endif
  if (p.ws == nullptr) grid.sync();
  XBAR();
  for (int layer = 0; layer < 2; ++layer) {
#ifndef SK_B
    phase_norm(p, layer, wv);
#endif
    XBAR();
#ifndef SK_C
    gemm_phase<0>(p, layer, smem, wv);
#endif
#ifdef DBL_C
    __syncthreads();
    gemm_phase<0>(p, layer, smem, wv);
#endif
    XBAR();
#ifndef SK_D
    phase_ret_kv(p, layer, smem, wv);
#endif
#ifdef DBL_D
    phase_ret_kv(p, layer, smem, wv);
#endif
    XBAR();
    phase_ret_prefix(p, layer, wv);
    XBAR();
#ifndef SK_E1
    phase_ret_out(p, layer, smem, wv);
#endif
#ifdef DBL_E1
    phase_ret_out(p, layer, smem, wv);
#endif
#ifndef SK_E2
    phase_rwkv_scan(p, layer, smem, wv);
#endif
#ifdef DBL_E2
    phase_rwkv_scan(p, layer, smem, wv);
#endif
    XBAR();
#ifndef SK_F
    phase_rwkv_readout(p, layer, wv);
#endif
#ifdef DBL_F
    phase_rwkv_readout(p, layer, wv);
#endif
    XBAR();
#ifndef SK_G
    gemm_phase<1>(p, layer, smem, wv);
#endif
    XBAR();
  }
  phase_final(p, wv);
}

extern "C" void kernel_launch(void* const* d_in, const int* in_sizes, int n_in, void* d_out, int out_size, void* d_ws,
                              size_t ws_size, hipStream_t stream) {
  static int grid_blocks = 0;
  if (!grid_blocks) {
    int dev = 0, cus = 0, per_cu = 0;
    hipGetDevice(&dev);
    hipDeviceGetAttribute(&cus, hipDeviceAttributeMultiprocessorCount, dev);
    hipOccupancyMaxActiveBlocksPerMultiprocessor(&per_cu, fwd_megakernel, NTHR, 0);
    if (per_cu < 1) per_cu = 1;
    grid_blocks = cus * per_cu;
    if (ws_size < WS_END) fprintf(stderr, "kernel_launch: workspace too small: %zu < %zu\n", ws_size, (size_t)WS_END);
  }
  Params p{};
  const float** pp = (const float**)&p;
  for (int i = 0; i < 22; ++i) pp[i] = (const float*)d_in[i];
  p.out = (float*)d_out;
  p.ws = (unsigned char*)d_ws;
  (void)hipMemsetAsync((unsigned char*)d_ws + OFF_BAR, 0, SZ_BAR, stream);
  void* args[] = {&p};
  hipError_t e = hipLaunchCooperativeKernel((void*)fwd_megakernel, dim3(grid_blocks), dim3(NTHR), args, 0, stream);
  if (e != hipSuccess) fprintf(stderr, "cooperative launch failed: %s (grid %d)\n", hipGetErrorString(e), grid_blocks);
}
```

```cpp
#include <hip/hip_runtime.h>
#include <hip/hip_fp16.h>
#include <hip/hip_cooperative_groups.h>
#include <cstdio>
namespace cg = cooperative_groups;

typedef _Float16 h16;
typedef _Float16 half8 __attribute__((ext_vector_type(8)));
typedef _Float16 half4 __attribute__((ext_vector_type(4)));
typedef float f32x4 __attribute__((ext_vector_type(4)));

constexpr int NB = 8, SEQ = 2048, CTXL = 256, DM = 1024;
constexpr int MLAT = NB * SEQ, MCTX = NB * CTXL, MTOT = MLAT + MCTX;
constexpr int DIN = 4224, HD = 64, DSHIFT = 1664;
constexpr int NTHR = 512;
constexpr float NORM_EPS = 1e-6f, GN_EPS = 64e-5f;

constexpr size_t OFF_P = 0;
constexpr size_t SZ_P = (size_t)MTOT * DIN * 2;
constexpr size_t OFF_H = OFF_P + SZ_P;
constexpr size_t SZ_H = (size_t)MTOT * DM * 2;
constexpr size_t OFF_Y = OFF_H + SZ_H;
constexpr size_t SZ_Y = (size_t)2 * MTOT * 512 * 2;
constexpr size_t OFF_XC = OFF_Y + SZ_Y;
constexpr size_t SZ_XC = (size_t)MCTX * DM * 4;
constexpr size_t OFF_WIN = OFF_XC + SZ_XC;
constexpr size_t SZ_WIN = (size_t)DIN * DM * 2;
constexpr size_t OFF_WOUT = OFF_WIN + 2 * SZ_WIN;
constexpr size_t SZ_WOUT = (size_t)DM * DM * 2;
constexpr size_t OFF_MOD = OFF_WOUT + 2 * SZ_WOUT;
constexpr size_t SZ_MOD = (size_t)2 * 9 * 3072 * 4;
constexpr size_t OFF_ROPE = OFF_MOD + SZ_MOD;
constexpr size_t SZ_ROPE = 64 * 16 * 2 * 4;
constexpr size_t OFF_BAR = OFF_ROPE + SZ_ROPE;
constexpr size_t SZ_BAR = 3456 * 4;
constexpr size_t WS_END = OFF_BAR + SZ_BAR;

constexpr size_t SEC_Q = 0, SEC_K = (size_t)MTOT * 512, SEC_V = (size_t)MTOT * 1024, SEC_GR = (size_t)MTOT * 1536,
                 SEC_RW = (size_t)MTOT * 2048, SEC_GW = (size_t)MTOT * 3712;

constexpr int SMEM_BYTES = 143360;

struct Params {
  const float *x, *c, *ctx, *c_ctx, *norm_w, *w_mod, *b_mod, *w_in, *ret_lg, *ret_nw, *shift_w, *w0, *w2, *a0, *a2,
      *k_k, *k_a, *r_k, *ln_w, *ln_b, *w_out, *fnw;
  float* out;
  unsigned char* ws;
};

__device__ __forceinline__ int TID(int w) {
  int t;
  asm volatile("v_mbcnt_lo_u32_b32 %0, -1, 0\n\tv_mbcnt_hi_u32_b32 %0, -1, %0\n\tv_lshl_or_b32 %0, %1, 6, %0" : "=&v"(t) : "s"(w));
  return t;
}
__device__ __forceinline__ int BID() { int t; asm volatile("s_mov_b32 %0, %1" : "=s"(t) : "s"((int)blockIdx.x)); return t; }

__device__ __forceinline__ float shx(float v, int lane, int m) {
  return __builtin_bit_cast(float, __builtin_amdgcn_ds_bpermute((lane ^ m) << 2, __builtin_bit_cast(int, v)));
}
__device__ __forceinline__ float wave_sum(float v, int lane) {
#pragma unroll
  for (int o = 1; o < 64; o <<= 1) v += shx(v, lane, o);
  return v;
}
template <int CTRL>
__device__ __forceinline__ float dppf(float x) {
  return __builtin_bit_cast(float, __builtin_amdgcn_update_dpp(0, __builtin_bit_cast(int, x), CTRL, 0xF, 0xF, true));
}
__device__ __forceinline__ float reduce8(float x) {
  x += dppf<0xB1>(x);
  x += dppf<0x4E>(x);
  x += dppf<0x141>(x);
  return x;
}
__device__ __forceinline__ float reduce16(float x) {
  x = reduce8(x);
  x += dppf<0x140>(x);
  return x;
}
__device__ __forceinline__ void lds_barrier() { asm volatile("s_waitcnt lgkmcnt(0)" ::: "memory"); __builtin_amdgcn_s_barrier(); asm volatile("" ::: "memory"); }
__device__ __forceinline__ float silu_f(float x) { return x / (1.f + expf(-x)); }

__device__ void transpose_item(const float* W, int N, h16* WT, int K, int item, float* tile, int wv) {
  const int tid = TID(wv);
  const int nblk = N / 64, kb = item / nblk, nbk = item % nblk, k0 = kb * 64, n0 = nbk * 64;
#pragma unroll
  for (int i = 0; i < 2; ++i) {
    const int r = (tid >> 4) + i * 32, c4 = (tid & 15) * 4;
    const float4 v = *(const float4*)(W + (size_t)(k0 + r) * N + n0 + c4);
    tile[r * 65 + c4 + 0] = v.x; tile[r * 65 + c4 + 1] = v.y; tile[r * 65 + c4 + 2] = v.z; tile[r * 65 + c4 + 3] = v.w;
  }
  __syncthreads();
  {
    const int n = tid >> 3, k8 = (tid & 7) * 8;
    half8 o;
#pragma unroll
    for (int i = 0; i < 8; ++i) o[i] = (h16)tile[(k8 + i) * 65 + n];
    *(half8*)(WT + (size_t)(n0 + n) * K + k0 + k8) = o;
  }
  __syncthreads();
}
__device__ void convert_weights(const Params& p, int blk, int nblk, unsigned char* smem, int wv) {
  constexpr int I_IN = (DM / 64) * (DIN / 64), I_OUT = (DM / 64) * (DM / 64), I_L = I_IN + I_OUT;
  float* tile = (float*)smem;
  for (int it = blk; it < 2 * I_L; it += nblk) {
    const int layer = it / I_L, r = it % I_L;
    if (r < I_IN) transpose_item(p.w_in + (size_t)layer * DM * DIN, DIN, (h16*)(p.ws + OFF_WIN + (size_t)layer * SZ_WIN), DM, r, tile, wv);
    else transpose_item(p.w_out + (size_t)layer * DM * DM, DM, (h16*)(p.ws + OFF_WOUT + (size_t)layer * SZ_WOUT), DM, r - I_IN, tile, wv);
  }
}

__device__ void phase_adaln(const Params& p_, unsigned char* smem, int wv) {
  (void)p_;
  auto kp_ = __builtin_amdgcn_kernarg_segment_ptr();
  asm volatile("" : "+s"(kp_));
  const Params p = *(const Params*)kp_;
  const int bid = BID();
  const int tid = TID(wv);
  float* scond = (float*)smem;
  float* red = scond + 9 * 1024;
  float* mod = (float*)(p.ws + OFF_MOD);
  const int nblocks = gridDim.x;
  if (bid == nblocks - 1) {
    float2* tab = (float2*)(p.ws + OFF_ROPE);
    for (int i = tid; i < 1024; i += NTHR) {
      const int pos = i >> 4, f = i & 15;
      const float inv = powf(10000.f, -(float)f * (1.f / 16.f));
      float sn, cs;
      sincosf((float)pos * inv, &sn, &cs);
      tab[i] = float2{cs, sn};
    }
  }
  if (bid < 96) {
    for (int i = tid; i < 9 * 1024; i += NTHR) {
      const int ci = i >> 10, k = i & 1023;
      const float v = ci < 8 ? p.c[ci * 1024 + k] : p.c_ctx[k];
      scond[i] = silu_f(v);
    }
    __syncthreads();
    for (int it = bid; it < 96; it += nblocks) {
      const int l = it / 48, nb = it % 48;
      const int kg = tid >> 6, nl = tid & 63, n = nb * 64 + nl;
      const float* wm = p.w_mod + (size_t)l * DM * 3072 + n;
      float acc[9];
#pragma unroll
      for (int i = 0; i < 9; ++i) acc[i] = 0.f;
#pragma unroll 4
      for (int k = kg * 128; k < kg * 128 + 128; ++k) {
        const float wv = wm[(size_t)k * 3072];
#pragma unroll
        for (int i = 0; i < 9; ++i) acc[i] += scond[i * 1024 + k] * wv;
      }
#pragma unroll
      for (int i = 0; i < 9; ++i) red[(kg * 9 + i) * 64 + nl] = acc[i];
      __syncthreads();
      for (int idx = tid; idx < 576; idx += NTHR) {
        const int i = idx >> 6, nn = idx & 63;
        float s = p.b_mod[l * 3072 + nb * 64 + nn];
#pragma unroll
        for (int g = 0; g < 8; ++g) s += red[(g * 9 + i) * 64 + nn];
        mod[((size_t)l * 9 + i) * 3072 + nb * 64 + nn] = s;
      }
      __syncthreads();
    }
    if (nblocks <= 96) convert_weights(p, bid, nblocks, smem, wv);
  } else {
    convert_weights(p, bid - 96, nblocks - 96, smem, wv);
  }
}

__device__ __forceinline__ const float* xrow_ptr(const Params& p, int layer, int row) {
  if (layer == 0) return row < MLAT ? p.x + (size_t)row * DM : p.ctx + (size_t)(row - MLAT) * DM;
  return row < MLAT ? p.out + (size_t)row * DM : (const float*)(p.ws + OFF_XC) + (size_t)(row - MLAT) * DM;
}
__device__ void phase_norm(const Params& p_, int layer, int wv) {
  (void)p_;
  auto kp_ = __builtin_amdgcn_kernarg_segment_ptr();
  asm volatile("" : "+s"(kp_));
  const Params p = *(const Params*)kp_;
  const int bid = BID();
  const int tid_ = TID(wv); const int lane = tid_ & 63, wave = tid_ >> 6;
  const float* mod = (const float*)(p.ws + OFF_MOD) + (size_t)layer * 9 * 3072;
  h16* H = (h16*)(p.ws + OFF_H);
  const float* nw = p.norm_w + layer * DM;
  const int nwv = gridDim.x * 8;
  for (int row = bid * 8 + wave; row < MTOT; row += 2 * nwv) {
    const int row2 = row + nwv;
    const bool has2 = row2 < MTOT;
    const float* xr = xrow_ptr(p, layer, row);
    const float* xr2 = xrow_ptr(p, layer, has2 ? row2 : row);
    float4 v[4], w[4];
    float ss = 0.f, ss2 = 0.f;
#pragma unroll
    for (int j = 0; j < 4; ++j) { v[j] = *(const float4*)(xr + j * 256 + lane * 4); w[j] = *(const float4*)(xr2 + j * 256 + lane * 4); }
#pragma unroll
    for (int j = 0; j < 4; ++j) {
      ss += v[j].x * v[j].x + v[j].y * v[j].y + v[j].z * v[j].z + v[j].w * v[j].w;
      ss2 += w[j].x * w[j].x + w[j].y * w[j].y + w[j].z * w[j].z + w[j].w * w[j].w;
    }
    ss = wave_sum(ss, lane);
    ss2 = wave_sum(ss2, lane);
#pragma unroll
    for (int q = 0; q < 2; ++q) {
      if (q == 1 && !has2) break;
      const int rr = q ? row2 : row;
      const float rstd = rsqrtf((q ? ss2 : ss) * (1.f / DM) + NORM_EPS);
      const int cond = rr < MLAT ? (rr >> 11) : 8;
      const float* sh = mod + cond * 3072;
      const float* sc = sh + 1024;
#pragma unroll
      for (int j = 0; j < 4; ++j) {
        const int col = j * 256 + lane * 4;
        const float4 x4 = q ? w[j] : v[j];
        const float4 w4 = *(const float4*)(nw + col), s4 = *(const float4*)(sc + col), h4 = *(const float4*)(sh + col);
        half4 o;
        o[0] = (h16)(x4.x * rstd * w4.x * (1.f + s4.x) + h4.x);
        o[1] = (h16)(x4.y * rstd * w4.y * (1.f + s4.y) + h4.y);
        o[2] = (h16)(x4.z * rstd * w4.z * (1.f + s4.z) + h4.z);
        o[3] = (h16)(x4.w * rstd * w4.w * (1.f + s4.w) + h4.w);
        *(half4*)(H + (size_t)rr * DM + col) = o;
      }
    }
  }
}

template <int MODE>
__device__ void gemm_phase(const Params& p_, int layer, unsigned char* smem, int wv) {
  (void)p_;
  auto kp_ = __builtin_amdgcn_kernarg_segment_ptr();
  asm volatile("" : "+s"(kp_));
  const Params p = *(const Params*)kp_;
  const int bid = BID();
  const int tid = TID(wv), lane = tid & 63, wave = tid >> 6;
  const int wm = wave >> 1, wn = wave & 1;
  const int Mrows = MODE == 0 ? MTOT : (layer == 0 ? MTOT : MLAT);
  const int N = MODE == 0 ? DIN : DM;
  const int nM = Mrows / 256, nN = N / 128;
  const h16* Wt = (const h16*)(p.ws + (MODE == 0 ? OFF_WIN + (size_t)layer * SZ_WIN : OFF_WOUT + (size_t)layer * SZ_WOUT));
  const h16* Abase = (const h16*)(p.ws + OFF_H);
  h16* sA = (h16*)smem;
  h16* sB = sA + 2 * 256 * 80;
  const int lr = lane & 15, lq = lane >> 4;
  if (__builtin_amdgcn_readfirstlane(tid) >= 256) __builtin_amdgcn_s_setprio(1);
  const int G = gridDim.x;
  const int nx = (G % 8 == 0) ? 8 : 1, per = G / nx;
  const int xcd = bid % nx, slot = bid / nx;
  const int total = nM * nN, fullN = (nN / 8) * 8;
  for (int it = 0;; ++it) {
    const int idx = (it * nx + xcd) * per + slot;
    if (idx >= total) break;
    int tm, tn;
    if (idx < nM * fullN) { const int panel = idx / (nM * 8), r = idx % (nM * 8); tm = r >> 3; tn = panel * 8 + (r & 7); }
    else { const int r = idx - nM * fullN, wrem = nN - fullN; tm = r / wrem; tn = fullN + r % wrem; }
    const int m0 = tm * 256, n0 = tn * 128;
    f32x4 acc[4][4];
#pragma unroll
    for (int i = 0; i < 4; ++i)
#pragma unroll
      for (int j = 0; j < 4; ++j) acc[i][j] = f32x4{0.f, 0.f, 0.f, 0.f};
    half8 ra[2][4], rb[2][2];
    const int ldrow = tid >> 3, ldcol = (tid & 7) * 8;
    const h16* aptr0 = (MODE == 0) ? Abase + (size_t)(m0 + ldrow) * DM + ldcol : Abase + (size_t)(m0 + ldrow) * 512 + ldcol;
    const h16* bptr0 = Wt + (size_t)(n0 + ldrow) * DM + ldcol;
#define APTR(KT) ((MODE == 0) ? aptr0 + (KT) * 64 : aptr0 + ((KT) < 8 ? (size_t)0 : (size_t)MTOT * 512) + ((KT) & 7) * 64)
#define ASTR ((size_t)64 * (MODE == 0 ? DM : 512))
#define GLOAD_PART(SET, KT, PART) do { \
      if ((PART) < 2) { const h16* ap_ = APTR(KT); ra[SET][2 * (PART)] = *(const half8*)(ap_ + (2 * (PART)) * ASTR); ra[SET][2 * (PART) + 1] = *(const half8*)(ap_ + (2 * (PART) + 1) * ASTR); } \
      else { rb[SET][0] = *(const half8*)(bptr0 + (KT) * 64); rb[SET][1] = *(const half8*)(bptr0 + (size_t)64 * DM + (KT) * 64); } } while (0)
#define SSTORE_PART(SET, BUF, PART) do { \
      if ((PART) < 2) { *(half8*)(sA + (size_t)(BUF) * 256 * 80 + (ldrow + (2 * (PART)) * 64) * 80 + ldcol) = ra[SET][2 * (PART)]; \
                        *(half8*)(sA + (size_t)(BUF) * 256 * 80 + (ldrow + (2 * (PART) + 1) * 64) * 80 + ldcol) = ra[SET][2 * (PART) + 1]; } \
      else { *(half8*)(sB + (size_t)(BUF) * 128 * 80 + ldrow * 80 + ldcol) = rb[SET][0]; *(half8*)(sB + (size_t)(BUF) * 128 * 80 + (ldrow + 64) * 80 + ldcol) = rb[SET][1]; } } while (0)
#define GLOAD(SET, KT) do { GLOAD_PART(SET, KT, 0); GLOAD_PART(SET, KT, 1); GLOAD_PART(SET, KT, 2); } while (0)
#define SSTORE(SET, BUF) do { SSTORE_PART(SET, BUF, 0); SSTORE_PART(SET, BUF, 1); SSTORE_PART(SET, BUF, 2); } while (0)
#define MMA8(KK, J0) do { \
      _Pragma("unroll") for (int j_ = (J0); j_ < (J0) + 2; ++j_) \
        _Pragma("unroll") for (int i_ = 0; i_ < 4; ++i_) acc[i_][j_] = __builtin_amdgcn_mfma_f32_16x16x32_f16(bf[KK][j_], af[KK][i_], acc[i_][j_], 0, 0, 0); } while (0)
#define STEP(BUF, SET, NBUF, KNEXT) do { \
      const h16* a_s = sA + (size_t)(BUF) * 256 * 80 + (wm * 64 + lr) * 80 + lq * 8; \
      const h16* b_s = sB + (size_t)(BUF) * 128 * 80 + (wn * 64 + lr) * 80 + lq * 8; \
      half8 af[2][4], bf[2][4]; \
      _Pragma("unroll") for (int kk = 0; kk < 2; ++kk) { \
        bf[kk][0] = *(const half8*)(b_s + kk * 32); \
        _Pragma("unroll") for (int i_ = 0; i_ < 4; ++i_) af[kk][i_] = *(const half8*)(a_s + i_ * 16 * 80 + kk * 32); \
        _Pragma("unroll") for (int j_ = 1; j_ < 4; ++j_) bf[kk][j_] = *(const half8*)(b_s + j_ * 16 * 80 + kk * 32); \
      } \
      __builtin_amdgcn_sched_barrier(0); \
      MMA8(0, 0); __builtin_amdgcn_sched_barrier(0); \
      SSTORE_PART(SET, NBUF, 0); GLOAD_PART(SET, KNEXT, 0); __builtin_amdgcn_sched_barrier(0); \
      MMA8(0, 2); __builtin_amdgcn_sched_barrier(0); \
      SSTORE_PART(SET, NBUF, 1); GLOAD_PART(SET, KNEXT, 1); __builtin_amdgcn_sched_barrier(0); \
      MMA8(1, 0); __builtin_amdgcn_sched_barrier(0); \
      SSTORE_PART(SET, NBUF, 2); GLOAD_PART(SET, KNEXT, 2); __builtin_amdgcn_sched_barrier(0); \
      MMA8(1, 2); __builtin_amdgcn_sched_barrier(0); \
      } while (0)
    constexpr int NK = DM / 64;
    GLOAD(0, 0);
    GLOAD(1, 1);
    SSTORE(0, 0);
    GLOAD(0, 2);
    lds_barrier();
#pragma unroll 1
    for (int kt = 0; kt < NK; kt += 2) {
      const int k3 = kt + 3 < NK ? kt + 3 : NK - 1, k4 = kt + 4 < NK ? kt + 4 : NK - 1;
      STEP(0, 1, 1, k3);
      lds_barrier();
      STEP(1, 0, 0, k4);
      lds_barrier();
    }
#undef GLOAD
#undef SSTORE
#undef GLOAD_PART
#undef SSTORE_PART
#undef MMA8
#undef STEP
#undef APTR
#undef ASTR
    if (MODE == 0) {
      h16* P = (h16*)(p.ws + OFF_P);
      size_t secoff; int stride, coff;
      if (n0 < 2048) { secoff = (size_t)MTOT * 512 * (n0 >> 9); stride = 512; coff = n0 & 511; }
      else if (n0 < 3712) { secoff = SEC_RW; stride = DSHIFT; coff = n0 - 2048; }
      else { secoff = SEC_GW; stride = 512; coff = n0 - 3712; }
#pragma unroll
      for (int i = 0; i < 4; ++i) {
        const int m = m0 + wm * 64 + i * 16 + lr;
#pragma unroll
        for (int j = 0; j < 4; ++j) {
          const int nl = wn * 64 + j * 16 + lq * 4;
          half4 o;
          o[0] = (h16)acc[i][j][0]; o[1] = (h16)acc[i][j][1]; o[2] = (h16)acc[i][j][2]; o[3] = (h16)acc[i][j][3];
          *(half4*)(P + secoff + (size_t)m * stride + coff + nl) = o;
        }
      }
    } else {
      const float* mod = (const float*)(p.ws + OFF_MOD) + (size_t)layer * 9 * 3072;
#pragma unroll
      for (int i = 0; i < 4; ++i) {
        const int m = m0 + wm * 64 + i * 16 + lr;
        const int cond = m < MLAT ? (m >> 11) : 8;
        const float* xo = xrow_ptr(p, layer, m);
        float* xn = m < MLAT ? p.out + (size_t)m * DM : (float*)(p.ws + OFF_XC) + (size_t)(m - MLAT) * DM;
#pragma unroll
        for (int j = 0; j < 4; ++j) {
          const int n = n0 + wn * 64 + j * 16 + lq * 4;
          const float4 g = *(const float4*)(mod + cond * 3072 + 2048 + n);
          const float4 xv = *(const float4*)(xo + n);
          float4 o;
          o.x = xv.x + g.x * acc[i][j][0]; o.y = xv.y + g.y * acc[i][j][1];
          o.z = xv.z + g.z * acc[i][j][2]; o.w = xv.w + g.w * acc[i][j][3];
          *(float4*)(xn + n) = o;
        }
      }
    }
  }
  __builtin_amdgcn_s_setprio(0);
}

__device__ __forceinline__ int chunk_row0(int b, int u) { return u < 2 ? MLAT + b * CTXL + u * 128 : b * SEQ + (u - 2) * 128; }

__device__ __forceinline__ void load_rope(const h16* src, const float2* tab, int qd, bool rope, int t, float scale, float* lo, float* hi) {
  const int hsel = qd >> 1, f0 = (qd & 1) * 8;
  const half8 a = *(const half8*)(src + hsel * 32 + f0);
  const half8 b = *(const half8*)(src + hsel * 32 + 16 + f0);
  if (rope) {
    const int pos = hsel == 0 ? (t >> 6) : (t & 63);
    const float2* tb = tab + pos * 16 + f0;
#pragma unroll
    for (int f = 0; f < 8; ++f) {
      const float2 cs = tb[f];
      const float x1 = (float)a[f], x2 = (float)b[f];
      lo[f] = (x1 * cs.x - x2 * cs.y) * scale;
      hi[f] = (x1 * cs.y + x2 * cs.x) * scale;
    }
  } else {
#pragma unroll
    for (int f = 0; f < 8; ++f) { lo[f] = (float)a[f] * scale; hi[f] = (float)b[f] * scale; }
  }
}

__device__ __forceinline__ void rope_regs(const half8 a, const half8 b, const float2* tab, int qd, bool rope, int t, float scale, float* lo, float* hi) {
  const int hsel = qd >> 1, f0 = (qd & 1) * 8;
  if (rope) {
    const int pos = hsel == 0 ? (t >> 6) : (t & 63);
    const float2* tb = tab + pos * 16 + f0;
#pragma unroll
    for (int f = 0; f < 8; ++f) {
      const float2 cs = tb[f];
      const float x1 = (float)a[f], x2 = (float)b[f];
      lo[f] = (x1 * cs.x - x2 * cs.y) * scale;
      hi[f] = (x1 * cs.y + x2 * cs.x) * scale;
    }
  } else {
#pragma unroll
    for (int f = 0; f < 8; ++f) { lo[f] = (float)a[f] * scale; hi[f] = (float)b[f] * scale; }
  }
}

__device__ __forceinline__ half4 lds_tr_read(unsigned addr) {
  half4 r;
  asm volatile("ds_read_b64_tr_b16 %0, %1" : "=&v"(r) : "v"(addr) : "memory");
  return r;
}
__device__ __forceinline__ unsigned lds_addr_of(const void* p_) {
  return (unsigned)(unsigned long)(__attribute__((address_space(3))) const void*)p_;
}

__device__ void phase_ret_kv(const Params& p_, int layer, unsigned char* smem, int wv) {
  (void)p_;
  auto kp_ = __builtin_amdgcn_kernarg_segment_ptr();
  asm volatile("" : "+s"(kp_));
  const Params p = *(const Params*)kp_;
  const int bid = BID();
  const int tid = TID(wv), lane = tid & 63, wave = tid >> 6;
  const int lr = lane & 15, lq = lane >> 4;
  const h16* P = (const h16*)(p.ws + OFF_P);
  h16* KVT = (h16*)(p.ws + OFF_H) + (size_t)MTOT * 512;
  h16* Vr = (h16*)smem;
  h16* Kf = Vr + 128 * 72;
  h16* Kb = Kf + 128 * 72;
  half8 rk0, rk1, rv0, rv1;
  auto fetch = [&](int it_) {
    const int bh_ = it_ / 18, u_ = it_ % 18;
    const size_t row_ = (size_t)(chunk_row0(bh_ >> 3, u_) + (tid >> 2));
    const int qd_ = tid & 3, hh = bh_ & 7;
    const h16* ks_ = P + SEC_K + row_ * 512 + hh * 64 + (qd_ >> 1) * 32 + (qd_ & 1) * 8;
    rk0 = *(const half8*)ks_; rk1 = *(const half8*)(ks_ + 16);
    const h16* vs_ = P + SEC_V + row_ * 512 + hh * 64 + qd_ * 16;
    rv0 = *(const half8*)vs_; rv1 = *(const half8*)(vs_ + 8);
  };
  if (bid < 64 * 18) fetch(bid);
  for (int it = bid; it < 64 * 18; it += gridDim.x) {
    const int bh = it / 18, u = it % 18, b = bh >> 3, h = bh & 7;
    const int row0 = chunk_row0(b, u);
    const float lgf = p.ret_lg[(layer * 2 + 0) * 8 + h], lgb = p.ret_lg[(layer * 2 + 1) * 8 + h];
    {
      const int j = tid >> 2, qd = tid & 3;
      const int t = (u < 2) ? 0 : (u - 2) * 128 + j;
      float lo[8], hi[8];
      rope_regs(rk0, rk1, (const float2*)(p.ws + OFF_ROPE), qd, u >= 2, t, 0.125f, lo, hi);
      const float df = expf(lgf * (float)(127 - j)), db = expf(lgb * (float)j);
      const int d0 = (qd >> 1) * 32 + (qd & 1) * 8;
      half8 fl, fh, bl, bh8;
#pragma unroll
      for (int f = 0; f < 8; ++f) { fl[f] = (h16)(lo[f] * df); fh[f] = (h16)(hi[f] * df); bl[f] = (h16)(lo[f] * db); bh8[f] = (h16)(hi[f] * db); }
      *(half8*)(Kf + j * 72 + d0) = fl; *(half8*)(Kf + j * 72 + d0 + 16) = fh;
      *(half8*)(Kb + j * 72 + d0) = bl; *(half8*)(Kb + j * 72 + d0 + 16) = bh8;
      *(half8*)(Vr + j * 72 + qd * 16) = rv0;
      *(half8*)(Vr + j * 72 + qd * 16 + 8) = rv1;
    }
    __syncthreads();
    if (it + (int)gridDim.x < 64 * 18) fetch(it + gridDim.x);
    {
      const int dir = wave >> 2, ei = wave & 3;
      const unsigned lane_off = (unsigned)(((lq * 8 + (lr >> 2)) * 72 + 4 * (lr & 3)) * 2);
      const unsigned vbase = lds_addr_of(Vr) + lane_off + (unsigned)(ei * 16 * 2);
      const unsigned kbase = lds_addr_of(dir ? Kb : Kf) + lane_off;
      half4 va[4][2], kb[4][4][2];
#pragma unroll
      for (int ks = 0; ks < 4; ++ks) {
        va[ks][0] = lds_tr_read(vbase + ks * 32 * 72 * 2);
        va[ks][1] = lds_tr_read(vbase + ks * 32 * 72 * 2 + 4 * 72 * 2);
#pragma unroll
        for (int jd = 0; jd < 4; ++jd) {
          kb[ks][jd][0] = lds_tr_read(kbase + ks * 32 * 72 * 2 + jd * 16 * 2);
          kb[ks][jd][1] = lds_tr_read(kbase + ks * 32 * 72 * 2 + jd * 16 * 2 + 4 * 72 * 2);
        }
      }
      f32x4 acc[4];
#pragma unroll
      for (int jd = 0; jd < 4; ++jd) acc[jd] = f32x4{0.f, 0.f, 0.f, 0.f};
#pragma unroll
      for (int ks = 0; ks < 4; ++ks) {
        asm volatile("s_waitcnt lgkmcnt(0)"
                     : "+v"(va[ks][0]), "+v"(va[ks][1]), "+v"(kb[ks][0][0]), "+v"(kb[ks][0][1]), "+v"(kb[ks][1][0]), "+v"(kb[ks][1][1]),
                       "+v"(kb[ks][2][0]), "+v"(kb[ks][2][1]), "+v"(kb[ks][3][0]), "+v"(kb[ks][3][1])
                     :: "memory");
        const half8 vf = {va[ks][0][0], va[ks][0][1], va[ks][0][2], va[ks][0][3], va[ks][1][0], va[ks][1][1], va[ks][1][2], va[ks][1][3]};
#pragma unroll
        for (int jd = 0; jd < 4; ++jd) {
          const half8 kf = {kb[ks][jd][0][0], kb[ks][jd][0][1], kb[ks][jd][0][2], kb[ks][jd][0][3],
                            kb[ks][jd][1][0], kb[ks][jd][1][1], kb[ks][jd][1][2], kb[ks][jd][1][3]};
          acc[jd] = __builtin_amdgcn_mfma_f32_16x16x32_f16(kf, vf, acc[jd], 0, 0, 0);
        }
      }
      h16* dst = KVT + (((size_t)dir * 64 + bh) * 18 + u) * 4096;
#pragma unroll
      for (int jd = 0; jd < 4; ++jd) {
        half4 o4;
#pragma unroll
        for (int r = 0; r < 4; ++r) o4[r] = (h16)acc[jd][r];
        *(half4*)(dst + (ei * 16 + lr) * 64 + jd * 16 + lq * 4) = o4;
      }
    }
    __syncthreads();
  }
}

__device__ void phase_ret_prefix(const Params& p_, int layer, int wv) {
  (void)p_;
  auto kp_ = __builtin_amdgcn_kernarg_segment_ptr();
  asm volatile("" : "+s"(kp_));
  const Params p = *(const Params*)kp_;
  const int bid = BID();
  const int tid = TID(wv);
  h16* KVT = (h16*)(p.ws + OFF_H) + (size_t)MTOT * 512;
  for (int idx = bid * NTHR + tid; idx < 128 * 512; idx += gridDim.x * NTHR) {
    const int seq = idx >> 9, e8 = (idx & 511) * 8;
    const int dir = seq >> 6, h = seq & 7;
    const float cd = expf(p.ret_lg[(layer * 2 + dir) * 8 + h] * 128.f);
    h16* base = KVT + (size_t)seq * 18 * 4096 + e8;
    half8 kv[18];
#pragma unroll
    for (int pp = 0; pp < 18; ++pp) {
      const int uu = dir == 0 ? pp : (pp < 2 ? 1 - pp : 19 - pp);
      kv[pp] = *(const half8*)(base + (size_t)uu * 4096);
    }
    float a[8];
#pragma unroll
    for (int i = 0; i < 8; ++i) a[i] = 0.f;
#pragma unroll
    for (int pp = 0; pp < 18; ++pp) {
      const int uu = dir == 0 ? pp : (pp < 2 ? 1 - pp : 19 - pp);
      half8 o;
#pragma unroll
      for (int i = 0; i < 8; ++i) o[i] = (h16)a[i];
      *(half8*)(base + (size_t)uu * 4096) = o;
#pragma unroll
      for (int i = 0; i < 8; ++i) a[i] = a[i] * cd + (float)kv[pp][i];
    }
  }
}

__device__ void phase_ret_out(const Params& p_, int layer, unsigned char* smem, int wv) {
  (void)p_;
  auto kp_ = __builtin_amdgcn_kernarg_segment_ptr();
  asm volatile("" : "+s"(kp_));
  const Params p = *(const Params*)kp_;
  const int bid = BID();
  const int tid = TID(wv), lane = tid & 63, wave = tid >> 6;
  const int lr = lane & 15, lq = lane >> 4;
  const h16* P = (const h16*)(p.ws + OFF_P);
  const h16* KVT = (const h16*)(p.ws + OFF_H) + (size_t)MTOT * 512;
  h16* MIXret = (h16*)(p.ws + OFF_H);
  h16* Qs = (h16*)smem;
  h16* Ks = Qs + 128 * 80;
  h16* VT = Ks + 128 * 80;
  h16* SC = VT + 64 * 144;
  h16* SfT = SC + 128 * 144;
  h16* SbT = SfT + 64 * 80;
  const int u_lo = layer == 0 ? 0 : 2, nu = 18 - u_lo;
  for (int it = bid; it < 64 * nu; it += gridDim.x) {
    const int bh = it / nu, u = u_lo + it % nu, b = bh >> 3, h = bh & 7;
    const int row0 = chunk_row0(b, u);
    const float lgf = p.ret_lg[(layer * 2 + 0) * 8 + h], lgb = p.ret_lg[(layer * 2 + 1) * 8 + h];
    {
      const int j = tid >> 2, qd = tid & 3;
      const size_t row = (size_t)(row0 + j);
      const int t = (u < 2) ? 0 : (u - 2) * 128 + j;
      const int d0 = (qd >> 1) * 32 + (qd & 1) * 8;
      float lo[8], hi[8];
      load_rope(P + SEC_Q + row * 512 + h * 64, (const float2*)(p.ws + OFF_ROPE), qd, u >= 2, t, 1.f, lo, hi);
      half8 o0, o1;
#pragma unroll
      for (int f = 0; f < 8; ++f) { o0[f] = (h16)lo[f]; o1[f] = (h16)hi[f]; }
      *(half8*)(Qs + j * 80 + d0) = o0; *(half8*)(Qs + j * 80 + d0 + 16) = o1;
      load_rope(P + SEC_K + row * 512 + h * 64, (const float2*)(p.ws + OFF_ROPE), qd, u >= 2, t, 0.125f, lo, hi);
#pragma unroll
      for (int f = 0; f < 8; ++f) { o0[f] = (h16)lo[f]; o1[f] = (h16)hi[f]; }
      *(half8*)(Ks + j * 80 + d0) = o0; *(half8*)(Ks + j * 80 + d0 + 16) = o1;
      const h16* vs = P + SEC_V + row * 512 + h * 64 + qd * 16;
      const half8 v0 = *(const half8*)vs, v1 = *(const half8*)(vs + 8);
#pragma unroll
      for (int f = 0; f < 8; ++f) { VT[(qd * 16 + f) * 144 + j] = v0[f]; VT[(qd * 16 + 8 + f) * 144 + j] = v1[f]; }
    }
    {
      const int e = tid >> 3, d8 = (tid & 7) * 8;
      const half8 of = *(const half8*)(KVT + (((size_t)0 * 64 + bh) * 18 + u) * 4096 + e * 64 + d8);
      const half8 ob = *(const half8*)(KVT + (((size_t)1 * 64 + bh) * 18 + u) * 4096 + e * 64 + d8);
      *(half8*)(SfT + e * 80 + d8) = of;
      *(half8*)(SbT + e * 80 + d8) = ob;
    }
    __syncthreads();
    {
      const int i_loc = wave * 16 + lr;
      half8 qf[2];
      qf[0] = *(const half8*)(Qs + i_loc * 80 + lq * 8);
      qf[1] = *(const half8*)(Qs + i_loc * 80 + 32 + lq * 8);
      const float l2f = lgf * 1.44269504f, l2b = lgb * 1.44269504f;
#pragma unroll
      for (int js = 0; js < 8; ++js) {
        f32x4 s = f32x4{0.f, 0.f, 0.f, 0.f};
#pragma unroll
        for (int kk = 0; kk < 2; ++kk) {
          const half8 kf = *(const half8*)(Ks + (js * 16 + lr) * 80 + kk * 32 + lq * 8);
          s = __builtin_amdgcn_mfma_f32_16x16x32_f16(kf, qf[kk], s, 0, 0, 0);
        }
        half4 o;
#pragma unroll
        for (int r = 0; r < 4; ++r) {
          const int j = js * 16 + lq * 4 + r;
          const int rel = i_loc - j;
          const float m = rel > 0 ? exp2f(l2f * (float)rel) : (rel < 0 ? exp2f(l2b * (float)(-rel)) : 2.f);
          o[r] = (h16)(s[r] * m);
        }
        *(half4*)(SC + i_loc * 144 + js * 16 + lq * 4) = o;
      }
    }
    __syncthreads();
    {
      const int i_loc = wave * 16 + lr;
      f32x4 ai[4], xf[4], xb[4];
#pragma unroll
      for (int je = 0; je < 4; ++je) { ai[je] = f32x4{0.f, 0.f, 0.f, 0.f}; xf[je] = ai[je]; xb[je] = ai[je]; }
#pragma unroll
      for (int ks = 0; ks < 4; ++ks) {
        const half8 sf = *(const half8*)(SC + i_loc * 144 + ks * 32 + lq * 8);
#pragma unroll
        for (int je = 0; je < 4; ++je) {
          const half8 vf = *(const half8*)(VT + (je * 16 + lr) * 144 + ks * 32 + lq * 8);
          ai[je] = __builtin_amdgcn_mfma_f32_16x16x32_f16(vf, sf, ai[je], 0, 0, 0);
        }
      }
#pragma unroll
      for (int kk = 0; kk < 2; ++kk) {
        const half8 qf = *(const half8*)(Qs + i_loc * 80 + kk * 32 + lq * 8);
#pragma unroll
        for (int je = 0; je < 4; ++je) {
          const half8 s1 = *(const half8*)(SfT + (je * 16 + lr) * 80 + kk * 32 + lq * 8);
          const half8 s2 = *(const half8*)(SbT + (je * 16 + lr) * 80 + kk * 32 + lq * 8);
          xf[je] = __builtin_amdgcn_mfma_f32_16x16x32_f16(s1, qf, xf[je], 0, 0, 0);
          xb[je] = __builtin_amdgcn_mfma_f32_16x16x32_f16(s2, qf, xb[je], 0, 0, 0);
        }
      }
      const float df = expf(lgf * (float)(i_loc + 1)), db = expf(lgb * (float)(128 - i_loc));
      float o[4][4], ss = 0.f;
#pragma unroll
      for (int je = 0; je < 4; ++je)
#pragma unroll
        for (int r = 0; r < 4; ++r) { o[je][r] = ai[je][r] + df * xf[je][r] + db * xb[je][r]; ss += o[je][r] * o[je][r]; }
      ss += shx(ss, lane, 16);
      ss += shx(ss, lane, 32);
      const float rn = rsqrtf(ss * (1.f / 64.f) + NORM_EPS);
      const size_t row = (size_t)(row0 + i_loc);
#pragma unroll
      for (int je = 0; je < 4; ++je) {
        const int e = je * 16 + lq * 4;
        const half4 g = *(const half4*)(P + SEC_GR + row * 512 + h * 64 + e);
        const float4 nw = *(const float4*)(p.ret_nw + layer * 512 + h * 64 + e);
        half4 res;
        res[0] = (h16)(o[je][0] * rn * nw.x * silu_f((float)g[0]));
        res[1] = (h16)(o[je][1] * rn * nw.y * silu_f((float)g[1]));
        res[2] = (h16)(o[je][2] * rn * nw.z * silu_f((float)g[2]));
        res[3] = (h16)(o[je][3] * rn * nw.w * silu_f((float)g[3]));
        *(half4*)(MIXret + row * 512 + h * 64 + e) = res;
      }
    }
    __syncthreads();
  }
}

typedef float f32x2 __attribute__((ext_vector_type(2)));
__device__ __forceinline__ f32x2 pk_fma(f32x2 a, f32x2 b, f32x2 c) { return __builtin_elementwise_fma(a, b, c); }

constexpr int SC_BUF_FLOATS = 32 * 64 * 2 + 32 * 4 * 64;

struct ScanOps { f32x4 kp0, kp1, b0, b1, m0, m1, r0, r1; float v; };
__device__ __forceinline__ void scan_load(ScanOps& o, const float* bufp, int st, int kq, int vrow) {
  const float* fd = bufp + 4096 + st * 256 + kq * 8;
  o.kp0 = *(const f32x4*)(fd + 192); o.kp1 = *(const f32x4*)(fd + 196);
  o.b0 = *(const f32x4*)(fd + 64); o.b1 = *(const f32x4*)(fd + 68);
  o.m0 = *(const f32x4*)(fd + 128); o.m1 = *(const f32x4*)(fd + 132);
  const float* rp = bufp + st * 64 + kq * 8;
  o.r0 = *(const f32x4*)rp; o.r1 = *(const f32x4*)(rp + 4);
  o.v = bufp[2048 + st * 64 + vrow];
}

__device__ void phase_rwkv_scan(const Params& p_, int layer, unsigned char* smem, int wv) {
  (void)p_;
  auto kp_ = __builtin_amdgcn_kernarg_segment_ptr();
  asm volatile("" : "+s"(kp_));
  const Params p = *(const Params*)kp_;
  const int bid = BID();
  const int tid = TID(wv), lane = tid & 63, wave = tid >> 6;
  const int lr = lane & 15, lq = lane >> 4;
  const h16* Prw = (const h16*)(p.ws + OFF_P) + SEC_RW;
  h16* Y = (h16*)(p.ws + OFF_Y);
  float* bufs = (float*)smem;
  float* ck = bufs + 2 * SC_BUF_FLOATS;
  float* sws = ck + 32 * 64;
  h16* xw16 = (h16*)(sws + 3 * 5 * 64 + 8);
  h16* xa16 = xw16 + 32 * 80;
  h16* w2h = xa16 + 32 * 80;
  h16* a2h = w2h + 64 * 80;
  float* scon = (float*)(a2h + 64 * 80);
  for (int it0 = bid; it0 < 256; it0 += gridDim.x) {
    int it = it0;
    if (gridDim.x == 256) { const int xcd = it0 & 7, slot = it0 >> 3; it = ((xcd * 8 + (slot >> 2)) << 2) | (slot & 3); }
    const int chain = it >> 1, rh = it & 1;
    const int b = chain >> 4, h = (chain >> 1) & 7, d = chain & 1;
    __syncthreads();
    for (int i = tid; i < 960; i += NTHR) {
      const int tap = i / 320, g = (i % 320) >> 6, c = i & 63;
      const int col = g < 3 ? g * 512 + h * 64 + c : 1536 + (g - 3) * 64 + c;
      ((h16*)sws)[i] = (h16)p.shift_w[((size_t)layer * 3 + tap) * DSHIFT + col];
    }
    if (tid < 8) ((h16*)sws)[960 + tid] = (h16)0.f;
    for (int i = tid; i < 4096; i += NTHR) {
      const int k = i >> 6, n = i & 63;
      w2h[n * 80 + k] = (h16)p.w2[(((size_t)layer * 2 + d) * 64 + k) * 512 + h * 64 + n];
      a2h[n * 80 + k] = (h16)p.a2[(((size_t)layer * 2 + d) * 64 + k) * 512 + h * 64 + n];
    }
    if (tid < 192) {
      const int w_ = tid >> 6, c = tid & 63;
      scon[tid] = w_ == 0 ? p.w0[(layer * 2 + d) * 512 + h * 64 + c] : (w_ == 1 ? p.a0[(layer * 2 + d) * 512 + h * 64 + c] : p.k_a[layer * 512 + h * 64 + c]);
    }
    __syncthreads();
    if (wave >= 4) {
      const int bw = wave - 4;
      const int st = bw * 8 + (lane >> 3), c8 = (lane & 7) * 8;
      const bool isA = (lr & 1) != 0;
      const int tokL = bw * 8 + (lr >> 1);
      const float4 kk0 = *(const float4*)(p.k_k + layer * 512 + h * 64 + c8);
      const float4 kk1 = *(const float4*)(p.k_k + layer * 512 + h * 64 + c8 + 4);
      half8 pf[5][3];
      auto prefetch = [&](int ci) {
        const bool isctx = ci < 8;
        const int lc = isctx ? ci : ci - 8;
        const int L = isctx ? CTXL : SEQ;
        const int rowbase = isctx ? MLAT + b * CTXL : b * SEQ;
        const int pos = lc * 32 + st;
        const int t = d ? L - 1 - pos : pos;
        const h16* rowp = Prw + (size_t)(rowbase + t) * DSHIFT + c8;
#pragma unroll
        for (int g = 0; g < 5; ++g) {
          const int col = (g < 3 ? g * 512 + h * 64 : 1536 + (g - 3) * 64);
          const h16* src = rowp + col;
          pf[g][1] = *(const half8*)src;
          pf[g][0] = *(const half8*)(src - (t > 0 ? DSHIFT : 0));
          pf[g][2] = *(const half8*)(src + (t < L - 1 ? DSHIFT : 0));
        }
      };
      auto build_conv = [&](float* bufp, int ci) {
        const bool isctx = ci < 8;
        const int pos_ = (isctx ? ci : ci - 8) * 32 + st;
        const int L_ = isctx ? CTXL : SEQ;
        const int t_ = d ? L_ - 1 - pos_ : pos_;
        const h16* swh = (const h16*)sws;
        const h16* swa = (t_ > 0) ? swh + c8 : swh + 960;
        const h16* swc = (t_ < L_ - 1) ? swh + 2 * 5 * 64 + c8 : swh + 960;
        const int gstr_a = (t_ > 0) ? 64 : 0, gstr_c = (t_ < L_ - 1) ? 64 : 0;
#pragma unroll
        for (int g = 0; g < 5; ++g) {
          const half8 wa = *(const half8*)(swa + g * gstr_a);
          const half8 wb = *(const half8*)(swh + (1 * 5 + g) * 64 + c8);
          const half8 wc = *(const half8*)(swc + g * gstr_c);
          const half8 oh = wa * pf[g][0] + wb * pf[g][1] + wc * pf[g][2];
          float o[8];
          if (g < 4) {
#pragma unroll
            for (int i = 0; i < 8; ++i) o[i] = (float)oh[i];
          }
          if (g < 3) {
            float* dst = (g == 0 ? bufp : (g == 1 ? ck : bufp + 2048)) + st * 64 + c8;
            *(float4*)dst = float4{o[0], o[1], o[2], o[3]};
            *(float4*)(dst + 4) = float4{o[4], o[5], o[6], o[7]};
            if (g == 1) {
              float kk[8] = {o[0] * kk0.x, o[1] * kk0.y, o[2] * kk0.z, o[3] * kk0.w, o[4] * kk1.x, o[5] * kk1.y, o[6] * kk1.z, o[7] * kk1.w};
              float ss = 0.f;
#pragma unroll
              for (int i = 0; i < 8; ++i) ss += kk[i] * kk[i];
              ss = reduce8(ss);
              const float inv = __builtin_amdgcn_rsqf(fmaxf(ss, 1e-24f));
              float* kd = bufp + 4096 + st * 256 + 192 + c8;
              *(float4*)kd = float4{kk[0] * inv, kk[1] * inv, kk[2] * inv, kk[3] * inv};
              *(float4*)(kd + 4) = float4{kk[4] * inv, kk[5] * inv, kk[6] * inv, kk[7] * inv};
            }
          } else {
            half8 ho;
            if (g == 3) {
#pragma unroll
              for (int i = 0; i < 8; ++i) ho[i] = (h16)(1.f - 2.f * __builtin_amdgcn_rcpf(1.f + __expf(2.f * o[i])));
            } else {
              ho = oh;
            }
            *(half8*)((g == 3 ? xw16 : xa16) + st * 80 + c8) = ho;
          }
        }
      };
      auto build_lora = [&](float* bufp) {
        half8 xwf[2], xaf[2];
#pragma unroll
        for (int kk = 0; kk < 2; ++kk) {
          xwf[kk] = *(const half8*)(xw16 + tokL * 80 + kk * 32 + lq * 8);
          xaf[kk] = *(const half8*)(xa16 + tokL * 80 + kk * 32 + lq * 8);
        }
        f32x4 aw[4], aa[4];
#pragma unroll
        for (int ns = 0; ns < 4; ++ns) {
          aw[ns] = f32x4{0.f, 0.f, 0.f, 0.f}; aa[ns] = aw[ns];
#pragma unroll
          for (int kk = 0; kk < 2; ++kk) {
            const half8 wf = *(const half8*)(w2h + (ns * 16 + lr) * 80 + kk * 32 + lq * 8);
            const half8 af = *(const half8*)(a2h + (ns * 16 + lr) * 80 + kk * 32 + lq * 8);
            aw[ns] = __builtin_amdgcn_mfma_f32_16x16x32_f16(wf, xwf[kk], aw[ns], 0, 0, 0);
            aa[ns] = __builtin_amdgcn_mfma_f32_16x16x32_f16(af, xaf[kk], aa[ns], 0, 0, 0);
          }
        }
        const bool hf = isA;
        const int tk = lr >> 1;
#pragma unroll
        for (int jj = 0; jj < 2; ++jj) {
          const int c = (hf ? 32 : 0) + jj * 16 + lq * 4;
          const f32x4 c0w = *(const f32x4*)(scon + c), c0a = *(const f32x4*)(scon + 64 + c), ka = *(const f32x4*)(scon + 128 + c);
          float sgw[4], sga[4], Lv[4];
#pragma unroll
          for (int r = 0; r < 4; ++r) {
            const float xw_ = c0w[r] + (hf ? aw[2 + jj][r] : aw[jj][r]);
            const float xa_ = c0a[r] + (hf ? aa[2 + jj][r] : aa[jj][r]);
            sgw[r] = __builtin_amdgcn_rcpf(1.f + __expf(-xw_));
            sga[r] = __builtin_amdgcn_rcpf(1.f + __expf(-xa_));
            float x = -0.60653066f * sgw[r];
            x += dppf<0x112>(x);
            x += dppf<0x114>(x);
            x += dppf<0x118>(x);
            Lv[r] = x;
          }
          float* fd = bufp + 4096 + tokL * 256 + c;
          float e[4], en[4], ep[4];
#pragma unroll
          for (int r = 0; r < 4; ++r) {
            e[r] = __expf(Lv[r]); en[r] = __builtin_amdgcn_rcpf(e[r]);
            const float pe = dppf<0x112>(e[r]);
            ep[r] = (tk == 0) ? 1.f : pe;
          }
          float* rp = bufp + tokL * 64 + c;
          const float4 rv = *(const float4*)rp;
          *(float4*)rp = float4{rv.x * e[0], rv.y * e[1], rv.z * e[2], rv.w * e[3]};
          const float4 kv = *(const float4*)(ck + tokL * 64 + c);
          const float4 kp = *(const float4*)(fd + 192);
          if (tk == 7) *(float4*)fd = float4{e[0], e[1], e[2], e[3]};
          *(float4*)(fd + 64) = float4{kp.x * sga[0] * en[0], kp.y * sga[1] * en[1], kp.z * sga[2] * en[2], kp.w * sga[3] * en[3]};
          *(float4*)(fd + 128) = float4{kv.x * (1.f + (sga[0] - 1.f) * ka[0]) * en[0], kv.y * (1.f + (sga[1] - 1.f) * ka[1]) * en[1],
                                        kv.z * (1.f + (sga[2] - 1.f) * ka[2]) * en[2], kv.w * (1.f + (sga[3] - 1.f) * ka[3]) * en[3]};
          *(float4*)(fd + 192) = float4{kp.x * ep[0], kp.y * ep[1], kp.z * ep[2], kp.w * ep[3]};
        }
      };
      prefetch(0);
      build_conv(bufs, 0);
      prefetch(1);
      build_lora(bufs);
      lds_barrier();
      for (int ci = 0; ci < 72; ++ci) {
        if (ci + 1 < 72) {
          float* bufp = bufs + ((ci + 1) & 1) * SC_BUF_FLOATS;
          build_conv(bufp, ci + 1);
          if (ci + 2 < 72) prefetch(ci + 2);
          build_lora(bufp);
        }
        lds_barrier();
      }
    } else {
      __builtin_amdgcn_s_setprio(0);
      const int kq = lane & 7, rsub = lane >> 3;
      const int vrow = rh * 32 + wave * 8 + rsub;
      f32x2 s0 = {0.f, 0.f}, s1 = s0, s2 = s0, s3 = s0;
      float ysel = 0.f;
      float yp[8];
      lds_barrier();
      for (int ci = 0; ci < 72; ++ci) {
        const bool isctx = ci < 8;
        const int lc = isctx ? ci : ci - 8;
        const int L = isctx ? CTXL : SEQ;
        const int rowbase = isctx ? MLAT + b * CTXL : b * SEQ;
        const float* bufp = bufs + (ci & 1) * SC_BUF_FLOATS;
        ScanOps cur, nxt;
        scan_load(cur, bufp, 0, kq, vrow);
#pragma unroll 1
        for (int s8 = 0; s8 < 32; s8 += 8) {
#pragma unroll
          for (int u = 0; u < 8; ++u) {
            const int st = s8 + u;
            scan_load(nxt, bufp, (st + 1) & 31, kq, vrow);
            f32x2 t2 = s0 * f32x2{cur.kp0[0], cur.kp0[1]};
            t2 = pk_fma(s1, f32x2{cur.kp0[2], cur.kp0[3]}, t2);
            t2 = pk_fma(s2, f32x2{cur.kp1[0], cur.kp1[1]}, t2);
            t2 = pk_fma(s3, f32x2{cur.kp1[2], cur.kp1[3]}, t2);
            const float sk = reduce8(t2[0] + t2[1]);
            const f32x2 nsk = {-sk, -sk}, vv = {cur.v, cur.v};
            s0 = pk_fma(vv, f32x2{cur.m0[0], cur.m0[1]}, pk_fma(nsk, f32x2{cur.b0[0], cur.b0[1]}, s0));
            s1 = pk_fma(vv, f32x2{cur.m0[2], cur.m0[3]}, pk_fma(nsk, f32x2{cur.b0[2], cur.b0[3]}, s1));
            s2 = pk_fma(vv, f32x2{cur.m1[0], cur.m1[1]}, pk_fma(nsk, f32x2{cur.b1[0], cur.b1[1]}, s2));
            s3 = pk_fma(vv, f32x2{cur.m1[2], cur.m1[3]}, pk_fma(nsk, f32x2{cur.b1[2], cur.b1[3]}, s3));
            f32x2 y2 = s0 * f32x2{cur.r0[0], cur.r0[1]};
            y2 = pk_fma(s1, f32x2{cur.r0[2], cur.r0[3]}, y2);
            y2 = pk_fma(s2, f32x2{cur.r1[0], cur.r1[1]}, y2);
            y2 = pk_fma(s3, f32x2{cur.r1[2], cur.r1[3]}, y2);
            yp[u] = y2[0] + y2[1];
            cur = nxt;
          }
          {
            const bool hiq = (kq & 4) != 0;
            float q4[4];
#pragma unroll
            for (int j = 0; j < 4; ++j) {
              const float keep = hiq ? yp[4 + j] : yp[j], send = hiq ? yp[j] : yp[4 + j];
              q4[j] = keep + dppf<0x141>(send);
            }
            const bool b0 = (kq & 1) != 0;
            float q2[2];
#pragma unroll
            for (int j = 0; j < 2; ++j) {
              const float keep = b0 ? q4[2 * j + 1] : q4[2 * j], send = b0 ? q4[2 * j] : q4[2 * j + 1];
              q2[j] = keep + dppf<0xB1>(send);
            }
            const bool b1 = (kq & 2) != 0;
            const float keep = b1 ? q2[1] : q2[0], send = b1 ? q2[0] : q2[1];
            ysel = keep + dppf<0x4E>(send);
          }
          {
            const float* gp = bufp + 4096 + (s8 + 7) * 256 + kq * 8;
            const f32x4 g0 = *(const f32x4*)gp, g1 = *(const f32x4*)(gp + 4);
            s0 = s0 * f32x2{g0[0], g0[1]}; s1 = s1 * f32x2{g0[2], g0[3]};
            s2 = s2 * f32x2{g1[0], g1[1]}; s3 = s3 * f32x2{g1[2], g1[3]};
            const int pos = lc * 32 + s8 + kq;
            const int t = d ? L - 1 - pos : pos;
            Y[((size_t)d * MTOT + rowbase + t) * 512 + h * 64 + vrow] = (h16)ysel;
          }
        }
        lds_barrier();
      }
      __builtin_amdgcn_s_setprio(0);
    }
  }
}

__device__ void phase_rwkv_readout(const Params& p_, int layer, int wv) {
  (void)p_;
  auto kp_ = __builtin_amdgcn_kernarg_segment_ptr();
  asm volatile("" : "+s"(kp_));
  const Params p = *(const Params*)kp_;
  const int bid = BID();
  const int tid_ = TID(wv); const int lane = tid_ & 63, wave = tid_ >> 6;
  const h16* P = (const h16*)(p.ws + OFF_P);
  const h16* Prw = P + SEC_RW;
  const h16* Y = (const h16*)(p.ws + OFF_Y);
  h16* MIXrw = (h16*)(p.ws + OFF_H) + (size_t)MTOT * 512;
  const int Mrows = layer == 0 ? MTOT : MLAT;
  const int head = lane >> 3, c0 = (lane & 7) * 8, ch = head * 64 + c0;
  float swr[3][3][8], rk[8], lw[8], lb[8];
  {
    const float* sw = p.shift_w + (size_t)layer * 3 * DSHIFT;
#pragma unroll
    for (int tap = 0; tap < 3; ++tap)
#pragma unroll
      for (int g = 0; g < 3; ++g)
#pragma unroll
        for (int i = 0; i < 8; ++i) swr[tap][g][i] = sw[tap * DSHIFT + g * 512 + ch + i];
#pragma unroll
    for (int i = 0; i < 8; ++i) { rk[i] = p.r_k[layer * 512 + ch + i]; lw[i] = p.ln_w[layer * 512 + ch + i]; lb[i] = p.ln_b[layer * 512 + ch + i]; }
  }
  for (int m = bid * 8 + wave; m < Mrows; m += gridDim.x * 8) {
    const int t = m < MLAT ? (m & (SEQ - 1)) : ((m - MLAT) & (CTXL - 1));
    const int L = m < MLAT ? SEQ : CTXL;
    const half8 yf = *(const half8*)(Y + (size_t)m * 512 + ch);
    const half8 yb = *(const half8*)(Y + ((size_t)MTOT + m) * 512 + ch);
    const half8 gw = *(const half8*)(P + SEC_GW + (size_t)m * 512 + ch);
    half8 pr[3][3];
#pragma unroll
    for (int g = 0; g < 3; ++g) {
      const h16* src = Prw + (size_t)m * DSHIFT + g * 512 + ch;
      pr[g][1] = *(const half8*)src;
      pr[g][0] = *(const half8*)(src - (t > 0 ? DSHIFT : 0));
      pr[g][2] = *(const half8*)(src + (t < L - 1 ? DSHIFT : 0));
    }
    const float m0 = t > 0 ? 1.f : 0.f, m2 = t < L - 1 ? 1.f : 0.f;
    float y[8], sum = 0.f;
#pragma unroll
    for (int i = 0; i < 8; ++i) { y[i] = (float)yf[i] + (float)yb[i]; sum += y[i]; }
    const float mu = reduce8(sum) * (1.f / 64.f);
    float vs = 0.f;
#pragma unroll
    for (int i = 0; i < 8; ++i) { y[i] -= mu; vs += y[i] * y[i]; }
    const float rstd = rsqrtf(reduce8(vs) * (1.f / 64.f) + GN_EPS);
    float cv[3][8];
#pragma unroll
    for (int g = 0; g < 3; ++g)
#pragma unroll
      for (int i = 0; i < 8; ++i)
        cv[g][i] = swr[0][g][i] * m0 * (float)pr[g][0][i] + swr[1][g][i] * (float)pr[g][1][i] + swr[2][g][i] * m2 * (float)pr[g][2][i];
    float dot = 0.f;
#pragma unroll
    for (int i = 0; i < 8; ++i) dot += cv[0][i] * cv[1][i] * rk[i];
    dot = reduce8(dot);
    half8 o;
#pragma unroll
    for (int i = 0; i < 8; ++i) {
      const float val = y[i] * rstd * lw[i] + lb[i] + dot * cv[2][i];
      o[i] = (h16)(val * silu_f((float)gw[i]));
    }
    *(half8*)(MIXrw + (size_t)m * 512 + ch) = o;
  }
}

__device__ void phase_final(const Params& p_, int wv) {
  (void)p_;
  auto kp_ = __builtin_amdgcn_kernarg_segment_ptr();
  asm volatile("" : "+s"(kp_));
  const Params p = *(const Params*)kp_;
  const int bid = BID();
  const int tid_ = TID(wv); const int lane = tid_ & 63, wave = tid_ >> 6;
  const int nwv = gridDim.x * 8;
  for (int row = bid * 8 + wave; row < MLAT; row += 2 * nwv) {
    const int row2 = row + nwv;
    const bool has2 = row2 < MLAT;
    float* xr = p.out + (size_t)row * DM;
    float* xr2 = p.out + (size_t)(has2 ? row2 : row) * DM;
    float4 v[4], w[4];
    float ss = 0.f, ss2 = 0.f;
#pragma unroll
    for (int j = 0; j < 4; ++j) { v[j] = *(const float4*)(xr + j * 256 + lane * 4); w[j] = *(const float4*)(xr2 + j * 256 + lane * 4); }
#pragma unroll
    for (int j = 0; j < 4; ++j) {
      ss += v[j].x * v[j].x + v[j].y * v[j].y + v[j].z * v[j].z + v[j].w * v[j].w;
      ss2 += w[j].x * w[j].x + w[j].y * w[j].y + w[j].z * w[j].z + w[j].w * w[j].w;
    }
    ss = wave_sum(ss, lane);
    ss2 = wave_sum(ss2, lane);
    const float rstd = rsqrtf(ss * (1.f / DM) + NORM_EPS), rstd2 = rsqrtf(ss2 * (1.f / DM) + NORM_EPS);
#pragma unroll
    for (int j = 0; j < 4; ++j) {
      const int col = j * 256 + lane * 4;
      const float4 w4 = *(const float4*)(p.fnw + col);
      float4 o;
      o.x = v[j].x * rstd * w4.x; o.y = v[j].y * rstd * w4.y; o.z = v[j].z * rstd * w4.z; o.w = v[j].w * rstd * w4.w;
      *(float4*)(xr + col) = o;
      if (has2) {
        float4 o2;
        o2.x = w[j].x * rstd2 * w4.x; o2.y = w[j].y * rstd2 * w4.y; o2.z = w[j].z * rstd2 * w4.z; o2.w = w[j].w * rstd2 * w4.w;
        *(float4*)(xr2 + col) = o2;
      }
    }
  }
}

#define XB_TMO      128
#define XB_XCNT(j)  (256  + 64 * (j))
#define XB_XSUB(j)  (1280 + 64 * (j))
#define XB_XGEN(j)  (2304 + 64 * (j))
#define XB_TOP      3328
#define XB_TOPGEN   3392
#define XCD_BAR_WORDS 3456
#define XB_SPIN_CAP (1u << 18)
#define LAS __attribute__((address_space(3)))
__device__ __forceinline__ unsigned xb_ld(unsigned* p)              { return __hip_atomic_load(p, __ATOMIC_RELAXED, __HIP_MEMORY_SCOPE_AGENT); }
__device__ __forceinline__ unsigned xb_add(unsigned* p, unsigned v) { return __hip_atomic_fetch_add(p, v, __ATOMIC_RELAXED, __HIP_MEMORY_SCOPE_AGENT); }
__device__ __forceinline__ unsigned xb_xcc_id() { return (unsigned)__builtin_amdgcn_s_getreg((3 << 11) | 20) & 0xFu; }
#define XB_SPIN(cond, bar) do { unsigned _sp = 0; while (cond) { __builtin_amdgcn_s_sleep(1); \
    if ((++_sp & 255u) == 0u) { if (xb_ld(&(bar)[XB_TMO])) break; if (_sp > XB_SPIN_CAP) { atomicAdd(&(bar)[XB_TMO], 1u); break; } } } } while (0)
struct XcdBarrier { unsigned* bar; unsigned x; volatile LAS unsigned* st; int wv; };
__device__ __forceinline__ XcdBarrier xcd_barrier_post(unsigned* bar, volatile LAS unsigned* st, int wv) {
    XcdBarrier b; b.bar = bar; b.x = xb_xcc_id(); b.st = st; b.wv = wv;
    if (TID(wv) == 0) (void)xb_add(&bar[XB_XCNT(b.x)], 1u);
    return b;
}
__device__ __forceinline__ void xcd_barrier_complete(unsigned* bar, unsigned x, unsigned& nloc, unsigned& nx) {
    const unsigned G = gridDim.x * gridDim.y * gridDim.z;
    unsigned sum, cnt, mine, sp = 0u;
    for (;;) {
        sum = 0u; cnt = 0u; mine = 0u;
#pragma unroll
        for (unsigned j = 0; j < 16; ++j) { const unsigned c = xb_ld(&bar[XB_XCNT(j)]); sum += c; cnt += (c > 0u) ? 1u : 0u; mine = (j == x) ? c : mine; }
        if (sum == G) break;
        __builtin_amdgcn_s_sleep(1);
        if ((++sp & 255u) == 0u) { if (xb_ld(&bar[XB_TMO])) break; if (sp > XB_SPIN_CAP) { atomicAdd(&bar[XB_TMO], 1u); break; } }
    }
    nloc = mine > 0u ? mine : 1u; nx = cnt > 0u ? cnt : 1u;
}
__device__ __forceinline__ void xcd_barrier(const XcdBarrier& b) {
    const int wv = b.wv;
    asm volatile("s_waitcnt vmcnt(0)" ::: "memory");
    __syncthreads();
    if (TID(wv) == 0) {
        unsigned* bar = b.bar;
        __builtin_amdgcn_s_waitcnt(0);
        unsigned nloc = b.st[0], nx = b.st[1];
        if (nloc == 0u) { xcd_barrier_complete(bar, b.x, nloc, nx); b.st[0] = nloc; b.st[1] = nx; }
        const unsigned old = xb_add(&bar[XB_XSUB(b.x)], 1u);
        const unsigned gen = old / nloc;
        if (old + 1u == (gen + 1u) * nloc) {
            __builtin_amdgcn_fence(__ATOMIC_RELEASE, "agent");
            asm volatile("s_waitcnt vmcnt(0)" ::: "memory");
            const unsigned og = xb_add(&bar[XB_TOP], 1u);
            const unsigned tg = og / nx;
            if (og + 1u == (tg + 1u) * nx) xb_add(&bar[XB_TOPGEN], 1u);
            else XB_SPIN(xb_ld(&bar[XB_TOPGEN]) == tg, bar);
            __builtin_amdgcn_fence(__ATOMIC_ACQUIRE, "agent");
            xb_add(&bar[XB_XGEN(b.x)], 1u);
            asm volatile("s_waitcnt vmcnt(0)" ::: "memory");
        } else {
            XB_SPIN(xb_ld(&bar[XB_XGEN(b.x)]) == gen, bar);
            __builtin_amdgcn_fence(__ATOMIC_ACQUIRE, "agent");
            asm volatile("s_waitcnt vmcnt(0)" ::: "memory");
        }
    }
    __syncthreads();
}

__global__ void __launch_bounds__(NTHR) fwd_megakernel(Params p) {
  __shared__ __attribute__((aligned(16))) unsigned char smem[SMEM_BYTES];
  cg::grid_group grid = cg::this_grid();
  const int wv = __builtin_amdgcn_readfirstlane((int)threadIdx.x >> 6);
  __shared__ uint4 xb_words;
  if (TID(wv) == 0) xb_words = make_uint4(0u, 0u, 0u, 0u);
  __syncthreads();
  (void)xcd_barrier_post((unsigned*)(p.ws + OFF_BAR), (volatile LAS unsigned*)&xb_words, wv);
#define XBAR() do { XcdBarrier xb_; xb_.bar = (unsigned*)(p.ws + OFF_BAR); xb_.x = xb_xcc_id(); xb_.st = (volatile LAS unsigned*)&xb_words; xb_.wv = wv; xcd_barrier(xb_); } while (0)
#ifndef SK_A
  phase_adaln(p, smem, wv);
#endif
  if (p.ws == nullptr) grid.sync();
  XBAR();
  for (int layer = 0; layer < 2; ++layer) {
#ifndef SK_B
    phase_norm(p, layer, wv);
#endif
    XBAR();
#ifndef SK_C
    gemm_phase<0>(p, layer, smem, wv);
#endif
#ifdef DBL_C
    __syncthreads();
    gemm_phase<0>(p, layer, smem, wv);
#endif
    XBAR();
#ifndef SK_D
    phase_ret_kv(p, layer, smem, wv);
#endif
#ifdef DBL_D
    phase_ret_kv(p, layer, smem, wv);
#endif
    XBAR();
    phase_ret_prefix(p, layer, wv);
    XBAR();
#ifndef SK_E1
    phase_ret_out(p, layer, smem, wv);
#endif
#ifdef DBL_E1
    phase_ret_out(p, layer, smem, wv);
#endif
#ifndef SK_E2
    phase_rwkv_scan(p, layer, smem, wv);
#endif
#ifdef DBL_E2
    phase_rwkv_scan(p, layer, smem, wv);
#endif
    XBAR();
#ifndef SK_F
    phase_rwkv_readout(p, layer, wv);
#endif
#ifdef DBL_F
    phase_rwkv_readout(p, layer, wv);
#endif
    XBAR();
#ifndef SK_G
    gemm_phase<1>(p, layer, smem, wv);
#endif
    XBAR();
  }
  phase_final(p, wv);
}

extern "C" void kernel_launch(void* const* d_in, const int* in_sizes, int n_in, void* d_out, int out_size, void* d_ws,
                              size_t ws_size, hipStream_t stream) {
  static int grid_blocks = 0;
  if (!grid_blocks) {
    int dev = 0, cus = 0, per_cu = 0;
    hipGetDevice(&dev);
    hipDeviceGetAttribute(&cus, hipDeviceAttributeMultiprocessorCount, dev);
    hipOccupancyMaxActiveBlocksPerMultiprocessor(&per_cu, fwd_megakernel, NTHR, 0);
    if (per_cu < 1) per_cu = 1;
    grid_blocks = cus * per_cu;
    if (ws_size < WS_END) fprintf(stderr, "kernel_launch: workspace too small: %zu < %zu\n", ws_size, (size_t)WS_END);
  }
  Params p{};
  const float** pp = (const float**)&p;
  for (int i = 0; i < 22; ++i) pp[i] = (const float*)d_in[i];
  p.out = (float*)d_out;
  p.ws = (unsigned char*)d_ws;
  (void)hipMemsetAsync((unsigned char*)d_ws + OFF_BAR, 0, SZ_BAR, stream);
  void* args[] = {&p};
  hipError_t e = hipLaunchCooperativeKernel((void*)fwd_megakernel, dim3(grid_blocks), dim3(NTHR), args, 0, stream);
  if (e != hipSuccess) fprintf(stderr, "cooperative launch failed: %s (grid %d)\n", hipGetErrorString(e), grid_blocks);
}
```
